# Optimizing an MI355X kernel written in HIP

```python
import jax, jax.numpy as jnp
from jax import lax
import numpy as np

D_MODEL = 1024
BATCH = 8
SEQ = 2048
DEPTH = 1

HEAD_DIM = 64
FOX_HEADS = 8
DIL_GROUPS = ((128, 1), (512, 4), (2048, 16))
DIL_HEADS_PER_GROUP = 4
N_DIL_GROUPS = len(DIL_GROUPS)
DIL_HEADS = N_DIL_GROUPS * DIL_HEADS_PER_GROUP
QK_HEADS = FOX_HEADS + DIL_HEADS
FOX_WIDTH = FOX_HEADS * HEAD_DIM
DIL_WIDTH = DIL_HEADS * HEAD_DIM
DIL_OUT_WIDTH = DIL_HEADS_PER_GROUP * HEAD_DIM
Q_BLOCK = 128
NUM_BUCKETS = 32
REL_MAX_DISTANCE = 2048
N_GROUPS = 4
EXPERTS_PER_GROUP = 8
N_EXPERTS = N_GROUPS * EXPERTS_PER_GROUP
TOP_K_IN_GROUP = 2
EXPERT_HIDDEN = D_MODEL // 2
MOE_BLOCK = 128
EPS = 1e-6

OFF_FOX_Q = 0
OFF_FOX_K = OFF_FOX_Q + FOX_WIDTH
OFF_FOX_V = OFF_FOX_K + FOX_WIDTH
OFF_FOX_F = OFF_FOX_V + FOX_WIDTH
OFF_DIL_Q = OFF_FOX_F + FOX_HEADS
OFF_DIL_K = OFF_DIL_Q + DIL_WIDTH
OFF_DIL_V = OFF_DIL_K + DIL_WIDTH
OFF_GATE_A = OFF_DIL_V + DIL_WIDTH
OFF_GATE_B = OFF_GATE_A + D_MODEL
N_IN = OFF_GATE_B + D_MODEL

kernel_name = 'hybrid_fox_dilated_hmoe_adaln'


def _rmsnorm(x, g):
    x32 = x.astype(jnp.float32)
    y = x32 * lax.rsqrt(jnp.mean(x32 * x32, axis=-1, keepdims=True) + EPS)
    return y.astype(x.dtype) * g


def _head_rms(t, g):
    t32 = t.astype(jnp.float32)
    y = t32 * lax.rsqrt(jnp.mean(t32 * t32, axis=-1, keepdims=True) + EPS)
    return y.astype(t.dtype) * g


def _t5_bucket(dist):
    max_exact = NUM_BUCKETS // 2
    d = np.maximum(dist, 1).astype(np.float32)
    large = max_exact + (np.log(d / max_exact) / np.log(REL_MAX_DISTANCE / max_exact)
                         * (NUM_BUCKETS - max_exact)).astype(np.int32)
    large = np.minimum(large, NUM_BUCKETS - 1)
    return np.where(dist < max_exact, dist, large).astype(np.int32)


def _forgetting_attention(q, k, v, log_f):
    B, S, H, E = q.shape
    scale = HEAD_DIM ** -0.5
    cum = jnp.cumsum(log_f, axis=1).transpose(0, 2, 1)
    outs = []
    for blk in range(S // Q_BLOCK):
        s0 = blk * Q_BLOCK
        s1 = s0 + Q_BLOCK
        logits = jnp.einsum('bqhe,bkhe->bhqk', q[:, s0:s1], k[:, :s1]).astype(jnp.float32) * scale
        logits = logits + cum[:, :, s0:s1, None] - cum[:, :, None, :s1]
        causal = np.arange(s0, s1)[:, None] >= np.arange(s1)[None, :]
        p = jax.nn.softmax(jnp.where(causal, logits, -jnp.inf), axis=-1)
        outs.append(jnp.einsum('bhqk,bkhe->bqhe', p.astype(v.dtype), v[:, :s1]))
    return jnp.concatenate(outs, axis=1)


def _dilated_group(q, k, v, table, window, dilation):
    B, S, H, E = q.shape
    L = window // dilation
    unit = L * dilation
    S_pad = -(-S // unit) * unit
    N = S_pad // dilation
    nb = N // L
    scale = HEAD_DIM ** -0.5

    def to_blocks(t):
        t = jnp.pad(t, ((0, 0), (0, S_pad - S), (0, 0), (0, 0)))
        t = t.reshape(B, N, dilation, H, E).transpose(0, 2, 1, 3, 4)
        return t.reshape(B, dilation, nb, L, H, E)

    def with_prev(t):
        prev = jnp.pad(t, ((0, 0), (0, 0), (1, 0), (0, 0), (0, 0), (0, 0)))[:, :, :-1]
        return jnp.concatenate([prev, t], axis=3)

    qb = to_blocks(q)
    kk = with_prev(to_blocks(k))
    vv = with_prev(to_blocks(v))
    i = np.arange(L)[:, None]
    j = np.arange(2 * L)[None, :]
    m = L + i - j
    band = (m >= 0) & (m <= L)
    first = band & (j >= L)
    valid = np.where(np.arange(nb)[:, None, None] == 0, first[None], band[None])
    bucket = _t5_bucket(np.clip(m, 0, None) * dilation)
    bias = table[bucket].transpose(2, 0, 1)
    logits = jnp.einsum('bdnqhe,bdnkhe->bdnhqk', qb, kk).astype(jnp.float32) * scale + bias
    logits = jnp.where(valid[None, None, :, None], logits, -jnp.inf)
    lse = jax.nn.logsumexp(logits, axis=-1)
    p = jnp.exp(logits - lse[..., None])
    o = jnp.einsum('bdnhqk,bdnkhe->bdnqhe', p.astype(v.dtype), vv)
    o = o.reshape(B, dilation, N, H, E).transpose(0, 2, 1, 3, 4).reshape(B, S_pad, H, E)[:, :S]
    lse = lse.transpose(0, 1, 2, 4, 3).reshape(B, dilation, N, H).transpose(0, 2, 1, 3).reshape(B, S_pad, H)[:, :S]
    return o, lse


def _mixer(h, rel_bias_table, w_in, b_forget, q_gain, k_gain, w_branch_a, w_branch_b, w_out):
    B, S, D = h.shape
    proj = h @ w_in
    qa = _head_rms(proj[..., OFF_FOX_Q:OFF_FOX_K].reshape(B, S, FOX_HEADS, HEAD_DIM), q_gain[:FOX_HEADS])
    ka = _head_rms(proj[..., OFF_FOX_K:OFF_FOX_V].reshape(B, S, FOX_HEADS, HEAD_DIM), k_gain[:FOX_HEADS])
    va = proj[..., OFF_FOX_V:OFF_FOX_F].reshape(B, S, FOX_HEADS, HEAD_DIM)
    log_f = jax.nn.log_sigmoid((proj[..., OFF_FOX_F:OFF_DIL_Q] + b_forget).astype(jnp.float32))
    ya = _forgetting_attention(qa, ka, va, log_f).reshape(B, S, FOX_WIDTH)
    qd = _head_rms(proj[..., OFF_DIL_Q:OFF_DIL_K].reshape(B, S, DIL_HEADS, HEAD_DIM), q_gain[FOX_HEADS:])
    kd = _head_rms(proj[..., OFF_DIL_K:OFF_DIL_V].reshape(B, S, DIL_HEADS, HEAD_DIM), k_gain[FOX_HEADS:])
    vd = proj[..., OFF_DIL_V:OFF_GATE_A].reshape(B, S, DIL_HEADS, HEAD_DIM)
    outs = []
    lses = []
    for g, (window, dilation) in enumerate(DIL_GROUPS):
        hs = slice(g * DIL_HEADS_PER_GROUP, (g + 1) * DIL_HEADS_PER_GROUP)
        o_g, lse_g = _dilated_group(qd[:, :, hs], kd[:, :, hs], vd[:, :, hs], rel_bias_table[:, hs], window, dilation)
        outs.append(o_g)
        lses.append(lse_g)
    wts = jax.nn.softmax(jnp.stack(lses, axis=0), axis=0)
    yd = jnp.sum(wts[..., None].astype(vd.dtype) * jnp.stack(outs, axis=0), axis=0).reshape(B, S, DIL_OUT_WIDTH)
    gate_a = jax.nn.sigmoid(proj[..., OFF_GATE_A:OFF_GATE_B])
    gate_b = jax.nn.sigmoid(proj[..., OFF_GATE_B:N_IN])
    merged = gate_a * (ya @ w_branch_a) + gate_b * (yd @ w_branch_b)
    return merged @ w_out


def _hier_moe(h, w_rg, b_rg, w_re, b_re, w1, w3, w2):
    B, S, D = h.shape
    T = B * S
    hf = h.reshape(T, D)
    g_logits = (hf @ w_rg + b_rg).astype(jnp.float32)
    g_prob = jax.nn.softmax(g_logits, axis=-1)
    g_idx = jnp.argmax(g_logits, axis=-1).astype(jnp.int32)
    g_w = jnp.take_along_axis(g_prob, g_idx[:, None], axis=1)
    e_logits = (hf @ w_re + b_re).astype(jnp.float32).reshape(T, N_GROUPS, EXPERTS_PER_GROUP)
    e_in = jnp.take_along_axis(e_logits, g_idx[:, None, None], axis=1)[:, 0]
    top_v, top_i = lax.top_k(e_in, TOP_K_IN_GROUP)
    weights = g_w * jax.nn.softmax(top_v, axis=-1)
    expert_ids = (g_idx[:, None] * EXPERTS_PER_GROUP + top_i).astype(jnp.int32)
    A = T * TOP_K_IN_GROUP
    flat_e = expert_ids.reshape(A)
    flat_tok = jnp.repeat(jnp.arange(T, dtype=jnp.int32), TOP_K_IN_GROUP)
    flat_w = weights.reshape(A)
    order = jnp.argsort(flat_e)
    sorted_e = flat_e[order]
    counts = jnp.zeros((N_EXPERTS,), jnp.int32).at[flat_e].add(1)
    starts = jnp.cumsum(counts) - counts
    padded = (counts + MOE_BLOCK - 1) // MOE_BLOCK * MOE_BLOCK
    pends = jnp.cumsum(padded)
    pstarts = pends - padded
    rank = jnp.arange(A, dtype=jnp.int32) - starts[sorted_e]
    dest = pstarts[sorted_e] + rank
    R = A + N_EXPERTS * MOE_BLOCK
    n_blk = R // MOE_BLOCK
    row_tok = jnp.full((R,), T, jnp.int32).at[dest].set(flat_tok[order])
    row_w = jnp.zeros((R,), jnp.float32).at[dest].set(flat_w[order])
    block_e = jnp.minimum(jnp.searchsorted(pends, jnp.arange(n_blk, dtype=jnp.int32) * MOE_BLOCK, side='right'),
                          N_EXPERTS - 1).astype(jnp.int32)
    xpad = jnp.concatenate([hf, jnp.zeros((1, D), hf.dtype)], axis=0)
    xs = xpad[row_tok].reshape(n_blk, MOE_BLOCK, D)

    def expert_block(args):
        xb, e = args
        return (jax.nn.silu(xb @ w1[e]) * (xb @ w3[e])) @ w2[e]

    y = lax.map(expert_block, (xs, block_e)).reshape(R, D)
    y = y * row_w[:, None].astype(y.dtype)
    out = jnp.zeros((T + 1, D), y.dtype).at[row_tok].add(y)[:T]
    return out.reshape(B, S, D)


def setup_inputs(seed: int = 0) -> dict:
    key = jax.random.key(seed)
    ks = jax.random.split(key, 21)

    def nrm(k, shape, scale):
        return jax.random.normal(k, shape, jnp.float32) * scale

    return {
        'x': nrm(ks[0], (BATCH, SEQ, D_MODEL), 1.0),
        'c': nrm(ks[1], (BATCH, D_MODEL), 1.0),
        'rel_bias_table': nrm(ks[2], (NUM_BUCKETS, DIL_HEADS), 0.5),
        'w_ada': nrm(ks[3], (DEPTH, D_MODEL, 6 * D_MODEL), D_MODEL ** -0.5),
        'b_ada': nrm(ks[4], (DEPTH, 6 * D_MODEL), 0.02),
        'norm1_g': 1.0 + nrm(ks[5], (DEPTH, D_MODEL), 0.02),
        'w_in': nrm(ks[6], (DEPTH, D_MODEL, N_IN), D_MODEL ** -0.5),
        'b_forget': 3.0 + nrm(ks[7], (DEPTH, FOX_HEADS), 0.1),
        'q_gain': 1.0 + nrm(ks[8], (DEPTH, QK_HEADS, HEAD_DIM), 0.02),
        'k_gain': 1.0 + nrm(ks[9], (DEPTH, QK_HEADS, HEAD_DIM), 0.02),
        'w_branch_a': nrm(ks[10], (DEPTH, FOX_WIDTH, D_MODEL), FOX_WIDTH ** -0.5),
        'w_branch_b': nrm(ks[11], (DEPTH, DIL_OUT_WIDTH, D_MODEL), DIL_OUT_WIDTH ** -0.5),
        'w_out': nrm(ks[12], (DEPTH, D_MODEL, D_MODEL), D_MODEL ** -0.5),
        'norm2_g': 1.0 + nrm(ks[13], (DEPTH, D_MODEL), 0.02),
        'w_router_group': nrm(ks[14], (DEPTH, D_MODEL, N_GROUPS), D_MODEL ** -0.5),
        'b_router_group': nrm(ks[15], (DEPTH, N_GROUPS), 0.01),
        'w_router_expert': nrm(ks[16], (DEPTH, D_MODEL, N_EXPERTS), D_MODEL ** -0.5),
        'b_router_expert': nrm(ks[17], (DEPTH, N_EXPERTS), 0.01),
        'w1': nrm(ks[18], (DEPTH, N_EXPERTS, D_MODEL, EXPERT_HIDDEN), D_MODEL ** -0.5),
        'w3': nrm(ks[19], (DEPTH, N_EXPERTS, D_MODEL, EXPERT_HIDDEN), D_MODEL ** -0.5),
        'w2': nrm(ks[20], (DEPTH, N_EXPERTS, EXPERT_HIDDEN, D_MODEL), EXPERT_HIDDEN ** -0.5),
    }


def reference(x, c, rel_bias_table, w_ada, b_ada, norm1_g, w_in, b_forget, q_gain, k_gain,
              w_branch_a, w_branch_b, w_out, norm2_g, w_router_group, b_router_group,
              w_router_expert, b_router_expert, w1, w3, w2):
    for l in range(DEPTH):
        mod = jax.nn.silu(c) @ w_ada[l] + b_ada[l]
        sh1, sc1, g1, sh2, sc2, g2 = jnp.split(mod, 6, axis=-1)
        h = _rmsnorm(x, norm1_g[l]) * (1 + sc1[:, None]) + sh1[:, None]
        x = x + g1[:, None] * _mixer(h, rel_bias_table, w_in[l], b_forget[l], q_gain[l], k_gain[l],
                                     w_branch_a[l], w_branch_b[l], w_out[l])
        h = _rmsnorm(x, norm2_g[l]) * (1 + sc2[:, None]) + sh2[:, None]
        x = x + g2[:, None] * _hier_moe(h, w_router_group[l], b_router_group[l], w_router_expert[l],
                                        b_router_expert[l], w1[l], w3[l], w2[l])
    return x
```

```cpp
#include <hip/hip_runtime.h>
#include <cstdio>
#include <cstdint>

#define LAS __attribute__((address_space(3)))
#define GAS __attribute__((address_space(1)))
typedef unsigned short bf16_t;
typedef short bf16x8 __attribute__((ext_vector_type(8)));
typedef short s16x4 __attribute__((ext_vector_type(4)));
typedef float f32x2 __attribute__((ext_vector_type(2)));
typedef float f32x4 __attribute__((ext_vector_type(4)));
typedef float f32x16 __attribute__((ext_vector_type(16)));
typedef unsigned u32x2 __attribute__((ext_vector_type(2)));
typedef unsigned u32x4 __attribute__((ext_vector_type(4)));
typedef __bf16 bf16x2_t __attribute__((ext_vector_type(2)));

constexpr int T_ = 16384, D_ = 1024, B_ = 8, S_ = 2048;
constexpr int NIN = 5896, NP = 5888;
constexpr int PC_FQ = 0, PC_FK = 512, PC_FV = 1024, PC_DQ = 1536, PC_DK = 2304, PC_DV = 3072, PC_GA = 3840, PC_GB = 4864;
constexpr int SRC_FORGET = 1536;
constexpr float EPS_ = 1e-6f, LOG2E = 1.4426950408889634f, C2 = 0.125f * 1.4426950408889634f;
constexpr int NEXP = 32, EH = 512;
constexpr int RMAX = 40960;

constexpr size_t MiB = 1u << 20;
constexpr size_t WS_CTL = 0, CTL_BYTES = 1 * MiB;
constexpr int CW_CNT = 256, CW_CUR = 512, CW_QUEUE = 768, CW_BAR = 4096;
constexpr size_t WS_MOD = 64 * 1024;
constexpr size_t WS_LOGF = 1 * MiB;
constexpr size_t WS_LSE = 1 * MiB + 512 * 1024;
constexpr size_t WS_TOKE = 2 * MiB + 512 * 1024;
constexpr size_t WS_TOKW = 2 * MiB + 768 * 1024;
constexpr size_t WS_TOKPOS = 3 * MiB;
constexpr size_t WS_WA = 8 * MiB, WS_WB = 9 * MiB, WS_WOUT = 10 * MiB, WS_WIN = 12 * MiB;
constexpr size_t WS_H = 24 * MiB;
constexpr size_t WS_PROJ = 56 * MiB;
constexpr size_t WS_YA = 240 * MiB;
constexpr size_t WS_OG = 256 * MiB;
constexpr size_t WS_YD = 280 * MiB;
constexpr size_t WS_END = 288 * MiB;
constexpr size_t WS_W13 = 56 * MiB, WS_W2T = 120 * MiB, WS_XS = 152 * MiB, WS_HID = 232 * MiB;

__device__ __forceinline__ float bf2f(bf16_t b) { return __uint_as_float(((unsigned)b) << 16); }
__device__ __forceinline__ unsigned pk2(float lo, float hi) { f32x2 v = {lo, hi}; bf16x2_t b = __builtin_convertvector(v, bf16x2_t); return __builtin_bit_cast(unsigned, b); }
__device__ __forceinline__ bf16_t f2bf(float f) { return (bf16_t)(pk2(f, 0.f) & 0xffffu); }
__device__ __forceinline__ float silu_f(float x) { return x / (1.f + __expf(-x)); }
__device__ __forceinline__ float sigmoid_f(float x) { return 1.f / (1.f + __expf(-x)); }
__device__ __forceinline__ float wave_sum(float v) {
#pragma unroll
    for (int o = 1; o < 64; o <<= 1) v += __shfl_xor(v, o);
    return v;
}

__constant__ unsigned char T5BUCKET[3][132] = {
{0,1,2,3,4,5,6,7,8,9,10,11,12,13,14,15,16,16,16,16,16,16,17,17,17,17,17,17,17,17,18,18,18,18,18,18,18,18,18,18,19,19,19,19,19,19,19,19,19,19,19,19,19,19,20,20,20,20,20,20,20,20,20,20,20,20,20,20,20,20,20,20,20,21,21,21,21,21,21,21,21,21,21,21,21,21,21,21,21,21,21,21,21,21,21,21,21,21,21,22,22,22,22,22,22,22,22,22,22,22,22,22,22,22,22,22,22,22,22,22,22,22,22,22,22,22,22,22,22,0,0,0},
{0,4,8,12,16,16,17,17,18,18,19,19,19,19,20,20,20,20,20,21,21,21,21,21,21,22,22,22,22,22,22,22,22,22,23,23,23,23,23,23,23,23,23,23,23,23,24,24,24,24,24,24,24,24,24,24,24,24,24,24,24,24,25,25,25,25,25,25,25,25,25,25,25,25,25,25,25,25,25,25,25,25,25,26,26,26,26,26,26,26,26,26,26,26,26,26,26,26,26,26,26,26,26,26,26,26,26,26,26,26,26,26,26,27,27,27,27,27,27,27,27,27,27,27,27,27,27,27,27,0,0,0},
{0,16,18,19,20,21,21,22,22,23,23,23,24,24,24,24,25,25,25,25,25,26,26,26,26,26,26,26,26,27,27,27,27,27,27,27,27,27,27,28,28,28,28,28,28,28,28,28,28,28,28,28,29,29,29,29,29,29,29,29,29,29,29,29,29,29,29,29,29,29,30,30,30,30,30,30,30,30,30,30,30,30,30,30,30,30,30,30,30,30,30,30,30,30,30,31,31,31,31,31,31,31,31,31,31,31,31,31,31,31,31,31,31,31,31,31,31,31,31,31,31,31,31,31,31,31,31,31,31,0,0,0}};

enum { I_X = 0, I_C, I_TABLE, I_WADA, I_BADA, I_N1G, I_WIN, I_BFORGET, I_QGAIN, I_KGAIN, I_WBA, I_WBB, I_WOUT, I_N2G, I_WRG, I_BRG, I_WRE, I_BRE, I_W1, I_W3, I_W2, N_INPUTS };
struct Args { const float* in[N_INPUTS]; float* out; unsigned char* ws; int ph_lo, ph_hi; };
static_assert(sizeof(Args) == (N_INPUTS + 2) * 8 + 8, "Args has no padding");
namespace nv {
__global__ void __launch_bounds__(256) k_mod(const float* c, const float* w_ada, const float* b_ada, float* mod) {
    const int j = blockIdx.x * 256 + threadIdx.x, b = blockIdx.y;
    float acc = b_ada[j];
    for (int k = 0; k < D_; ++k) acc += silu_f(c[b * D_ + k]) * w_ada[(size_t)k * 6144 + j];
    mod[b * 6144 + j] = acc;
}
__global__ void __launch_bounds__(256) k_norm1(const float* x, const float* mod, const float* n1g, const float* w_in, const float* b_forget, bf16_t* H, float* logf) {
    const int lane = threadIdx.x & 63, t = blockIdx.x * 4 + (threadIdx.x >> 6), b = t / S_;
    const float* xr = x + (size_t)t * D_;
    float v[16]; float ss = 0.f;
    for (int i = 0; i < 16; ++i) { v[i] = xr[lane + 64 * i]; ss += v[i] * v[i]; }
    const float rstd = rsqrtf(wave_sum(ss) * (1.f / D_) + EPS_);
    float z[8] = {0, 0, 0, 0, 0, 0, 0, 0};
    for (int i = 0; i < 16; ++i) { const int cidx = lane + 64 * i;
        const float hv = v[i] * rstd * n1g[cidx] * (1.f + mod[b * 6144 + 1024 + cidx]) + mod[b * 6144 + cidx];
        H[(size_t)t * D_ + cidx] = f2bf(hv);
        for (int hh = 0; hh < 8; ++hh) z[hh] += hv * w_in[(size_t)cidx * NIN + SRC_FORGET + hh]; }
    for (int hh = 0; hh < 8; ++hh) { const float zz = wave_sum(z[hh]) + b_forget[hh];
        const float lf = fminf(zz, 0.f) - log1pf(__expf(-fabsf(zz)));
        if (lane == 0) logf[((size_t)b * 8 + hh) * S_ + (t % S_)] = lf; }
}
template <class AF, class BF, class CF>
__global__ void __launch_bounds__(256) k_sgemm(int M, int N, int K, int pad_, AF af, BF bfn, CF cf) {
    __shared__ float As[16][68], Bs[16][68];
    const int tx = threadIdx.x & 15, ty = threadIdx.x >> 4, m0 = blockIdx.y * 64, n0 = blockIdx.x * 64;
    float acc[4][4] = {};
    for (int k0 = 0; k0 < K; k0 += 16) {
        for (int i = threadIdx.x; i < 1024; i += 256) { const int kk = i & 15, mm = i >> 4; As[kk][mm] = af(m0 + mm, k0 + kk); }
        for (int i = threadIdx.x; i < 1024; i += 256) { const int nn = i & 63, kk = i >> 6; Bs[kk][nn] = (n0 + nn < N) ? bfn(k0 + kk, n0 + nn) : 0.f; }
        __syncthreads();
#pragma unroll
        for (int kk = 0; kk < 16; ++kk) { float a[4], bb[4];
#pragma unroll
            for (int i = 0; i < 4; ++i) { a[i] = As[kk][ty * 4 + i]; bb[i] = Bs[kk][tx * 4 + i]; }
#pragma unroll
            for (int i = 0; i < 4; ++i)
#pragma unroll
                for (int j = 0; j < 4; ++j) acc[i][j] += a[i] * bb[j]; }
        __syncthreads();
    }
    for (int i = 0; i < 4; ++i) for (int j = 0; j < 4; ++j) if (n0 + tx * 4 + j < N) cf(m0 + ty * 4 + i, n0 + tx * 4 + j, acc[i][j]);
}
struct ABf16 { const bf16_t* p; long ld; __device__ float operator()(int m, int k) const { return bf2f(p[(size_t)m * ld + k]); } };
struct BF32 { const float* p; long ld; __device__ float operator()(int k, int n) const { return p[(size_t)k * ld + n]; } };
struct BWin { const float* p; __device__ float operator()(int k, int n) const { return p[(size_t)k * NIN + (n < SRC_FORGET ? n : n + 8)]; } };
struct CProjRaw { bf16_t* p; __device__ void operator()(int m, int n, float v) const { p[(size_t)m * NP + n] = f2bf(v); } };
__global__ void __launch_bounds__(256) k_proj_fix(bf16_t* P, const float* qg, const float* kg) {
    const size_t id = (size_t)blockIdx.x * 256 + threadIdx.x; if (id >= (size_t)T_ * 92) return;
    const int t = (int)(id / 92), ch = (int)(id % 92), c0 = ch * 64;
    bf16_t* p = P + (size_t)t * NP + c0;
    int kind = 0; const float* g = nullptr; float sc = 1.f;
    if (c0 < PC_FK) { kind = 1; g = qg + ch * 64; sc = C2; }
    else if (c0 < PC_FV) { kind = 1; g = kg + (ch - 8) * 64; }
    else if (c0 < PC_DQ) kind = 0;
    else if (c0 < PC_DK) { kind = 1; g = qg + (8 + ch - 24) * 64; sc = C2; }
    else if (c0 < PC_DV) { kind = 1; g = kg + (8 + ch - 36) * 64; }
    else if (c0 < PC_GA) kind = 0;
    else kind = 2;
    if (kind == 0) return;
    float v[64]; float ss = 0.f;
    for (int i = 0; i < 64; ++i) { v[i] = bf2f(p[i]); ss += v[i] * v[i]; }
    if (kind == 1) { const float r = rsqrtf(ss * (1.f / 64.f) + EPS_) * sc; for (int i = 0; i < 64; ++i) p[i] = f2bf(v[i] * r * g[i]); }
    else for (int i = 0; i < 64; ++i) p[i] = f2bf(sigmoid_f(v[i]));
}
__global__ void __launch_bounds__(256) k_fox(const bf16_t* P, const float* logf, bf16_t* YA) {
    __shared__ float cum2[S_];
    const int bh = blockIdx.x >> 3, qb = blockIdx.x & 7, b = bh >> 3, h = bh & 7, t = qb * 256 + threadIdx.x;
    if (threadIdx.x == 0) { float c = 0.f; for (int s = 0; s < (qb + 1) * 256; ++s) { c += logf[(size_t)bh * S_ + s]; cum2[s] = c * LOG2E; } }
    __syncthreads();
    const bf16_t* qp = P + ((size_t)(b * S_ + t)) * NP + PC_FQ + h * 64;
    float q[64], o[64]; for (int i = 0; i < 64; ++i) { q[i] = bf2f(qp[i]); o[i] = 0.f; }
    float m = -1e30f, l = 0.f;
    const int smax = qb * 256 + 255;
    for (int s = 0; s <= smax; ++s) {
        const bf16_t* kp = P + ((size_t)(b * S_ + s)) * NP + PC_FK + h * 64; const bf16_t* vp = kp + (PC_FV - PC_FK);
        float d = 0.f; for (int i = 0; i < 64; ++i) d += q[i] * bf2f(kp[i]);
        const float y = d - cum2[s];
        if (s <= t) { const float mn = fmaxf(m, y), a = exp2f(m - mn), p = exp2f(y - mn); l = l * a + p; m = mn;
            for (int i = 0; i < 64; ++i) o[i] = o[i] * a + p * bf2f(vp[i]); }
    }
    const float rl = 1.f / l; bf16_t* op = YA + (size_t)(b * S_ + t) * 512 + h * 64;
    for (int i = 0; i < 64; ++i) op[i] = f2bf(o[i] * rl);
}
__global__ void __launch_bounds__(256) k_dil(const bf16_t* P, const float* table, bf16_t* OG, float* LSE) {
    const int id = blockIdx.x * 256 + threadIdx.x, t = id % S_, hd = (id / S_) % 12, b = id / (S_ * 12);
    const int g = hd >> 2, slot = hd & 3, d = (g == 0) ? 1 : (g == 1 ? 4 : 16);
    const bf16_t* qp = P + ((size_t)(b * S_ + t)) * NP + PC_DQ + hd * 64;
    float q[64], o[64]; for (int i = 0; i < 64; ++i) { q[i] = bf2f(qp[i]); o[i] = 0.f; }
    float m = -1e30f, l = 0.f;
    for (int mm = 0; mm <= 128; ++mm) { const int s = t - mm * d; if (s < 0) break;
        const bf16_t* kp = P + ((size_t)(b * S_ + s)) * NP + PC_DK + hd * 64; const bf16_t* vp = kp + (PC_DV - PC_DK);
        float dd = 0.f; for (int i = 0; i < 64; ++i) dd += q[i] * bf2f(kp[i]);
        const float y = dd + table[T5BUCKET[g][mm] * 12 + hd] * LOG2E;
        const float mn = fmaxf(m, y), a = exp2f(m - mn), p = exp2f(y - mn); l = l * a + p; m = mn;
        for (int i = 0; i < 64; ++i) o[i] = o[i] * a + p * bf2f(vp[i]); }
    const float rl = 1.f / l; bf16_t* op = OG + ((size_t)g * T_ + (b * S_ + t)) * 256 + slot * 64;
    for (int i = 0; i < 64; ++i) op[i] = f2bf(o[i] * rl);
    LSE[((size_t)g * T_ + (b * S_ + t)) * 4 + slot] = m + log2f(l);
}
__global__ void __launch_bounds__(256) k_combine(const bf16_t* OG, const float* LSE, bf16_t* YD) {
    const size_t id = (size_t)blockIdx.x * 256 + threadIdx.x; const int t = (int)(id >> 8), c = (int)(id & 255), slot = c >> 6;
    float l0 = LSE[((size_t)0 * T_ + t) * 4 + slot], l1 = LSE[((size_t)1 * T_ + t) * 4 + slot], l2 = LSE[((size_t)2 * T_ + t) * 4 + slot];
    const float mx = fmaxf(l0, fmaxf(l1, l2)); l0 = exp2f(l0 - mx); l1 = exp2f(l1 - mx); l2 = exp2f(l2 - mx); const float r = 1.f / (l0 + l1 + l2);
    const float v = (l0 * bf2f(OG[((size_t)0 * T_ + t) * 256 + c]) + l1 * bf2f(OG[((size_t)1 * T_ + t) * 256 + c]) + l2 * bf2f(OG[((size_t)2 * T_ + t) * 256 + c])) * r;
    YD[(size_t)t * 256 + c] = f2bf(v);
}
struct CBranchA { bf16_t* Mg; const bf16_t* P; __device__ void operator()(int m, int n, float v) const { Mg[(size_t)m * D_ + n] = f2bf(v * bf2f(P[(size_t)m * NP + PC_GA + n])); } };
struct CBranchB { bf16_t* Mg; const bf16_t* P; __device__ void operator()(int m, int n, float v) const { Mg[(size_t)m * D_ + n] = f2bf(bf2f(Mg[(size_t)m * D_ + n]) + v * bf2f(P[(size_t)m * NP + PC_GB + n])); } };
struct COut { float* x1; const float* x; const float* mod; __device__ void operator()(int m, int n, float v) const { x1[(size_t)m * D_ + n] = x[(size_t)m * D_ + n] + mod[(m / S_) * 6144 + 2048 + n] * v; } };
__global__ void __launch_bounds__(256) k_norm2(const float* x1, const float* mod, const float* n2g, const float* w_rg, const float* b_rg, const float* w_re, const float* b_re, bf16_t* H2, int* toke, float* tokw) {
    const int lane = threadIdx.x & 63, t = blockIdx.x * 4 + (threadIdx.x >> 6), b = t / S_;
    const float* xr = x1 + (size_t)t * D_;
    float v[16]; float ss = 0.f;
    for (int i = 0; i < 16; ++i) { v[i] = xr[lane + 64 * i]; ss += v[i] * v[i]; }
    const float rstd = rsqrtf(wave_sum(ss) * (1.f / D_) + EPS_);
    float gl[4] = {0, 0, 0, 0};
    for (int i = 0; i < 16; ++i) { const int c = lane + 64 * i;
        v[i] = v[i] * rstd * n2g[c] * (1.f + mod[b * 6144 + 4096 + c]) + mod[b * 6144 + 3072 + c];
        H2[(size_t)t * D_ + c] = f2bf(v[i]);
        for (int g = 0; g < 4; ++g) gl[g] += v[i] * w_rg[c * 4 + g]; }
    int gi = 0; float gm = -1e30f, gs = 0.f;
    for (int g = 0; g < 4; ++g) { gl[g] = wave_sum(gl[g]) + b_rg[g]; if (gl[g] > gm) { gm = gl[g]; gi = g; } }
    for (int g = 0; g < 4; ++g) gs += __expf(gl[g] - gm);
    const float gw = 1.f / gs;
    float el[8] = {0, 0, 0, 0, 0, 0, 0, 0};
    for (int i = 0; i < 16; ++i) { const int c = lane + 64 * i; for (int e = 0; e < 8; ++e) el[e] += v[i] * w_re[c * 32 + gi * 8 + e]; }
    int i0 = 0, i1 = 0; float v0 = -1e30f, v1 = -1e30f;
    for (int e = 0; e < 8; ++e) { el[e] = wave_sum(el[e]) + b_re[gi * 8 + e];
        if (el[e] > v0) { v1 = v0; i1 = i0; v0 = el[e]; i0 = e; } else if (el[e] > v1) { v1 = el[e]; i1 = e; } }
    const float e1 = __expf(v1 - v0), w0 = gw / (1.f + e1), w1 = gw * e1 / (1.f + e1);
    if (lane == 0) { toke[t * 2] = gi * 8 + i0; toke[t * 2 + 1] = gi * 8 + i1; tokw[t * 2] = w0; tokw[t * 2 + 1] = w1; }
}
__global__ void __launch_bounds__(256) k_moe(const bf16_t* H2, const int* toke, const float* w1, const float* w3, const float* w2, bf16_t* Yt) {
    __shared__ float hs[D_], hid[EH];
    const int t = blockIdx.x >> 1, k = blockIdx.x & 1, e = toke[t * 2 + k];
    for (int i = threadIdx.x; i < D_; i += 256) hs[i] = bf2f(H2[(size_t)t * D_ + i]);
    __syncthreads();
    const float* W1 = w1 + (size_t)e * D_ * EH; const float* W3 = w3 + (size_t)e * D_ * EH; const float* W2 = w2 + (size_t)e * EH * D_;
    for (int j = threadIdx.x; j < EH; j += 256) { float a = 0.f, u = 0.f; for (int kk = 0; kk < D_; ++kk) { a += hs[kk] * W1[(size_t)kk * EH + j]; u += hs[kk] * W3[(size_t)kk * EH + j]; } hid[j] = silu_f(a) * u; }
    __syncthreads();
    for (int n = threadIdx.x; n < D_; n += 256) { float a = 0.f; for (int j = 0; j < EH; ++j) a += hid[j] * W2[(size_t)j * D_ + n]; Yt[((size_t)t * 2 + k) * D_ + n] = f2bf(a); }
}
__global__ void __launch_bounds__(256) k_final(float* out, const float* mod, const bf16_t* Yt, const float* tokw) {
    const size_t id = (size_t)blockIdx.x * 256 + threadIdx.x; const int t = (int)(id >> 10), n = (int)(id & 1023), b = t / S_;
    const float y = tokw[t * 2] * bf2f(Yt[((size_t)t * 2) * D_ + n]) + tokw[t * 2 + 1] * bf2f(Yt[((size_t)t * 2 + 1) * D_ + n]);
    out[id] = out[id] + mod[b * 6144 + 5120 + n] * y;
}
}
static void launch_naive_mixer(const Args& a, hipStream_t st, int from_stage) {
    unsigned char* ws = a.ws;
    float* mod = (float*)(ws + WS_MOD); float* logf = (float*)(ws + WS_LOGF); float* lse = (float*)(ws + WS_LSE);
    bf16_t* H = (bf16_t*)(ws + WS_H); bf16_t* P = (bf16_t*)(ws + WS_PROJ); bf16_t* YA = (bf16_t*)(ws + WS_YA); bf16_t* OG = (bf16_t*)(ws + WS_OG); bf16_t* YD = (bf16_t*)(ws + WS_YD);
    bf16_t* MG = (bf16_t*)(ws + WS_H);
    if (from_stage <= 0) nv::k_mod<<<dim3(24, 8), 256, 0, st>>>(a.in[I_C], a.in[I_WADA], a.in[I_BADA], mod);
    if (from_stage <= 1) nv::k_norm1<<<T_ / 4, 256, 0, st>>>(a.in[I_X], mod, a.in[I_N1G], a.in[I_WIN], a.in[I_BFORGET], H, logf);
    if (from_stage <= 2) { nv::k_sgemm<<<dim3(NP / 64, T_ / 64), 256, 0, st>>>(T_, NP, D_, 0, nv::ABf16{H, D_}, nv::BWin{a.in[I_WIN]}, nv::CProjRaw{P});
        nv::k_proj_fix<<<(T_ * 92 + 255) / 256, 256, 0, st>>>(P, a.in[I_QGAIN], a.in[I_KGAIN]); }
    if (from_stage <= 3) { nv::k_dil<<<B_ * 12 * S_ / 256, 256, 0, st>>>(P, a.in[I_TABLE], OG, lse);
        nv::k_fox<<<512, 256, 0, st>>>(P, logf, YA);
        nv::k_combine<<<T_, 256, 0, st>>>(OG, lse, YD); }
    if (from_stage <= 4) { nv::k_sgemm<<<dim3(D_ / 64, T_ / 64), 256, 0, st>>>(T_, D_, 512, 0, nv::ABf16{YA, 512}, nv::BF32{a.in[I_WBA], D_}, nv::CBranchA{MG, P});
        nv::k_sgemm<<<dim3(D_ / 64, T_ / 64), 256, 0, st>>>(T_, D_, 256, 0, nv::ABf16{YD, 256}, nv::BF32{a.in[I_WBB], D_}, nv::CBranchB{MG, P}); }
    if (from_stage <= 5) nv::k_sgemm<<<dim3(D_ / 64, T_ / 64), 256, 0, st>>>(T_, D_, D_, 0, nv::ABf16{MG, D_}, nv::BF32{a.in[I_WOUT], D_}, nv::COut{a.out, a.in[I_X], mod});
}
static void launch_naive_moe(const Args& a, hipStream_t st, int from_stage) {
    unsigned char* ws = a.ws;
    float* mod = (float*)(ws + WS_MOD);
    bf16_t* H2 = (bf16_t*)(ws + WS_H); int* toke = (int*)(ws + WS_TOKE); float* tokw = (float*)(ws + WS_TOKW); bf16_t* Yt = (bf16_t*)(ws + WS_XS);
    if (from_stage <= 6) nv::k_norm2<<<T_ / 4, 256, 0, st>>>(a.out, mod, a.in[I_N2G], a.in[I_WRG], a.in[I_BRG], a.in[I_WRE], a.in[I_BRE], H2, toke, tokw);
    if (from_stage <= 7) { nv::k_moe<<<T_ * 2, 256, 0, st>>>(H2, toke, a.in[I_W1], a.in[I_W3], a.in[I_W2], Yt);
        nv::k_final<<<T_ * D_ / 256, 256, 0, st>>>(a.out, mod, Yt, tokw); }
}
extern "C" void kernel_launch(void* const* d_in, const int* in_sizes, int n_in, void* d_out, int out_size, void* d_ws, size_t ws_size, hipStream_t stream) {
    if (n_in != N_INPUTS || out_size != T_ * D_ || ws_size < WS_END) { fprintf(stderr, "kernel_launch: unexpected shapes n_in %d out %d ws %zu\n", n_in, out_size, ws_size); return; }
    Args a{};
    for (int i = 0; i < N_INPUTS; ++i) a.in[i] = (const float*)d_in[i];
    a.out = (float*)d_out; a.ws = (unsigned char*)d_ws; a.ph_lo = 0; a.ph_hi = 0;
    launch_naive_mixer(a, stream, 0);
    launch_naive_moe(a, stream, 0);
}
```

```cpp
#include <hip/hip_runtime.h>
#include <cstdio>
#include <cstdint>

#define LAS __attribute__((address_space(3)))
#define GAS __attribute__((address_space(1)))
typedef unsigned short bf16_t;
typedef short bf16x8 __attribute__((ext_vector_type(8)));
typedef short s16x4 __attribute__((ext_vector_type(4)));
typedef float f32x2 __attribute__((ext_vector_type(2)));
typedef float f32x4 __attribute__((ext_vector_type(4)));
typedef float f32x16 __attribute__((ext_vector_type(16)));
typedef unsigned u32x2 __attribute__((ext_vector_type(2)));
typedef unsigned u32x4 __attribute__((ext_vector_type(4)));
typedef __bf16 bf16x2_t __attribute__((ext_vector_type(2)));

constexpr int T_ = 16384, D_ = 1024, B_ = 8, S_ = 2048;
constexpr int NIN = 5896, NP = 5888;
constexpr int PC_FQ = 0, PC_FK = 512, PC_FV = 1024, PC_DQ = 1536, PC_DK = 2304, PC_DV = 3072, PC_GA = 3840, PC_GB = 4864;
constexpr int SRC_FORGET = 1536;
constexpr float EPS_ = 1e-6f, LOG2E = 1.4426950408889634f, C2 = 0.125f * 1.4426950408889634f;
constexpr int NEXP = 32, EH = 512;
constexpr int RMAX = 40960;

constexpr size_t MiB = 1u << 20;
constexpr size_t WS_CTL = 0, CTL_BYTES = 1 * MiB;
constexpr int CW_CNT = 256, CW_CUR = 512, CW_QUEUE = 768, CW_BAR = 4096;
constexpr size_t WS_MOD = 64 * 1024;
constexpr size_t WS_LOGF = 1 * MiB;
constexpr size_t WS_LSE = 1 * MiB + 512 * 1024;
constexpr size_t WS_TOKE = 2 * MiB + 512 * 1024;
constexpr size_t WS_TOKW = 2 * MiB + 768 * 1024;
constexpr size_t WS_TOKPOS = 3 * MiB;
constexpr size_t WS_WA = 8 * MiB, WS_WB = 9 * MiB, WS_WOUT = 10 * MiB, WS_WIN = 12 * MiB;
constexpr size_t WS_H = 24 * MiB;
constexpr size_t WS_PROJ = 56 * MiB;
constexpr size_t WS_YA = 240 * MiB;
constexpr size_t WS_OG = 256 * MiB;
constexpr size_t WS_YD = 280 * MiB;
constexpr size_t WS_END = 288 * MiB;
constexpr size_t WS_W13 = 56 * MiB, WS_W2T = 120 * MiB, WS_XS = 152 * MiB, WS_HID = 232 * MiB;

__device__ __forceinline__ float bf2f(bf16_t b) { return __uint_as_float(((unsigned)b) << 16); }
__device__ __forceinline__ unsigned pk2(float lo, float hi) { f32x2 v = {lo, hi}; bf16x2_t b = __builtin_convertvector(v, bf16x2_t); return __builtin_bit_cast(unsigned, b); }
__device__ __forceinline__ bf16_t f2bf(float f) { return (bf16_t)(pk2(f, 0.f) & 0xffffu); }
__device__ __forceinline__ float silu_f(float x) { return x / (1.f + __expf(-x)); }
__device__ __forceinline__ float sigmoid_f(float x) { return 1.f / (1.f + __expf(-x)); }
__device__ __forceinline__ float wave_sum(float v) {
#pragma unroll
    for (int o = 1; o < 64; o <<= 1) v += __shfl_xor(v, o);
    return v;
}

__constant__ unsigned char T5BUCKET[3][132] = {
{0,1,2,3,4,5,6,7,8,9,10,11,12,13,14,15,16,16,16,16,16,16,17,17,17,17,17,17,17,17,18,18,18,18,18,18,18,18,18,18,19,19,19,19,19,19,19,19,19,19,19,19,19,19,20,20,20,20,20,20,20,20,20,20,20,20,20,20,20,20,20,20,20,21,21,21,21,21,21,21,21,21,21,21,21,21,21,21,21,21,21,21,21,21,21,21,21,21,21,22,22,22,22,22,22,22,22,22,22,22,22,22,22,22,22,22,22,22,22,22,22,22,22,22,22,22,22,22,22,0,0,0},
{0,4,8,12,16,16,17,17,18,18,19,19,19,19,20,20,20,20,20,21,21,21,21,21,21,22,22,22,22,22,22,22,22,22,23,23,23,23,23,23,23,23,23,23,23,23,24,24,24,24,24,24,24,24,24,24,24,24,24,24,24,24,25,25,25,25,25,25,25,25,25,25,25,25,25,25,25,25,25,25,25,25,25,26,26,26,26,26,26,26,26,26,26,26,26,26,26,26,26,26,26,26,26,26,26,26,26,26,26,26,26,26,26,27,27,27,27,27,27,27,27,27,27,27,27,27,27,27,27,0,0,0},
{0,16,18,19,20,21,21,22,22,23,23,23,24,24,24,24,25,25,25,25,25,26,26,26,26,26,26,26,26,27,27,27,27,27,27,27,27,27,27,28,28,28,28,28,28,28,28,28,28,28,28,28,29,29,29,29,29,29,29,29,29,29,29,29,29,29,29,29,29,29,30,30,30,30,30,30,30,30,30,30,30,30,30,30,30,30,30,30,30,30,30,30,30,30,30,31,31,31,31,31,31,31,31,31,31,31,31,31,31,31,31,31,31,31,31,31,31,31,31,31,31,31,31,31,31,31,31,31,31,0,0,0}};

enum { I_X = 0, I_C, I_TABLE, I_WADA, I_BADA, I_N1G, I_WIN, I_BFORGET, I_QGAIN, I_KGAIN, I_WBA, I_WBB, I_WOUT, I_N2G, I_WRG, I_BRG, I_WRE, I_BRE, I_W1, I_W3, I_W2, N_INPUTS };
struct Args { const float* in[N_INPUTS]; float* out; unsigned char* ws; int ph_lo, ph_hi; };
static_assert(sizeof(Args) == (N_INPUTS + 2) * 8 + 8, "Args has no padding");
namespace mk {
constexpr int NWAVES = 8, NTHR = 512;
constexpr int LDS_SCRATCH = 147456;
constexpr int LDS_CTL = LDS_SCRATCH;
constexpr int LDS_BYTES = LDS_SCRATCH + 1024;
constexpr int LC_BAR = 8, LC_CNT = 16, LC_BASE = 48, LC_TST = 80, LC_BC = 120;

#define LDS_WAIT() asm volatile("s_waitcnt lgkmcnt(0)" ::: "memory")
#define VM_WAIT() asm volatile("s_waitcnt vmcnt(0)" ::: "memory")

#define XB_TMO      128
#define XB_XCNT(j)  (256  + 64 * (j))
#define XB_XSUB(j)  (1280 + 64 * (j))
#define XB_XGEN(j)  (2304 + 64 * (j))
#define XB_TOP      3328
#define XB_TOPGEN   3392
#define XCD_BAR_WORDS 3456
#define XB_SPIN_CAP (1u << 18)

__device__ __forceinline__ unsigned xb_ld(unsigned* p)              { return __hip_atomic_load(p, __ATOMIC_RELAXED, __HIP_MEMORY_SCOPE_AGENT); }
__device__ __forceinline__ unsigned xb_add(unsigned* p, unsigned v) { return __hip_atomic_fetch_add(p, v, __ATOMIC_RELAXED, __HIP_MEMORY_SCOPE_AGENT); }
__device__ __forceinline__ unsigned xb_xcc_id() { return (unsigned)__builtin_amdgcn_s_getreg((3 << 11) | 20) & 0xFu; }
#define XB_SPIN(cond, bar) do { unsigned _sp = 0; while (cond) { __builtin_amdgcn_s_sleep(1); \
    if ((++_sp & 255u) == 0u) { if (xb_ld(&(bar)[XB_TMO])) break; if (_sp > XB_SPIN_CAP) { atomicAdd(&(bar)[XB_TMO], 1u); break; } } } } while (0)

struct XcdBarrier {
    unsigned* bar; unsigned x;
    volatile LAS unsigned* st;
};

__device__ __forceinline__ XcdBarrier xcd_barrier_post(unsigned* bar, volatile LAS unsigned* st) {
    XcdBarrier b; b.bar = bar; b.x = xb_xcc_id(); b.st = st;
    if (threadIdx.x == 0) (void)xb_add(&bar[XB_XCNT(b.x)], 1u);
    return b;
}
__device__ __forceinline__ void xcd_barrier_complete(unsigned* bar, unsigned x, unsigned& nloc, unsigned& nx) {
    const unsigned G = gridDim.x * gridDim.y * gridDim.z;
    unsigned sum, cnt, mine, sp = 0u;
    for (;;) {
        sum = 0u; cnt = 0u; mine = 0u;
#pragma unroll
        for (unsigned j = 0; j < 16; ++j) { const unsigned c = xb_ld(&bar[XB_XCNT(j)]); sum += c; cnt += (c > 0u) ? 1u : 0u; mine = (j == x) ? c : mine; }
        if (sum == G) break;
        __builtin_amdgcn_s_sleep(1);
        if ((++sp & 255u) == 0u) { if (xb_ld(&bar[XB_TMO])) break; if (sp > XB_SPIN_CAP) { atomicAdd(&bar[XB_TMO], 1u); break; } }
    }
    nloc = mine > 0u ? mine : 1u; nx = cnt > 0u ? cnt : 1u;
}

__device__ __forceinline__ void xcd_barrier(const XcdBarrier& b) {
    asm volatile("s_waitcnt vmcnt(0)" ::: "memory");
    __syncthreads();
    if (threadIdx.x == 0) {
        unsigned* bar = b.bar;
        __builtin_amdgcn_s_waitcnt(0);
        unsigned nloc = b.st[0], nx = b.st[1];
        if (nloc == 0u) { xcd_barrier_complete(bar, b.x, nloc, nx); b.st[0] = nloc; b.st[1] = nx; }
        const unsigned old = xb_add(&bar[XB_XSUB(b.x)], 1u);
        const unsigned gen = old / nloc;
        if (old + 1u == (gen + 1u) * nloc) {
            __builtin_amdgcn_fence(__ATOMIC_RELEASE, "agent");
            asm volatile("s_waitcnt vmcnt(0)" ::: "memory");
            const unsigned og = xb_add(&bar[XB_TOP], 1u);
            const unsigned tg = og / nx;
            if (og + 1u == (tg + 1u) * nx) xb_add(&bar[XB_TOPGEN], 1u);
            else XB_SPIN(xb_ld(&bar[XB_TOPGEN]) == tg, bar);
            __builtin_amdgcn_fence(__ATOMIC_ACQUIRE, "agent");
            xb_add(&bar[XB_XGEN(b.x)], 1u);
            asm volatile("s_waitcnt vmcnt(0)" ::: "memory");
        } else {
            XB_SPIN(xb_ld(&bar[XB_XGEN(b.x)]) == gen, bar);
            __builtin_amdgcn_fence(__ATOMIC_ACQUIRE, "agent");
            asm volatile("s_waitcnt vmcnt(0)" ::: "memory");
        }
    }
    __syncthreads();
}

namespace pg8 {
constexpr int BM = 256, BK = 64, HALF = 128, HTB = HALF * BK * 2, STAGE_BYTES = 8 * HTB, NXCD = 8, WGM = 8;
__host__ __device__ __forceinline__ int lds_byte(int r, int c) { const int st = (r >> 4) * 2 + (c >> 5), rr = r & 15, cc = c & 31, ob = rr * 64 + cc * 2; return st * 1024 + (ob ^ (((ob >> 9) & 1) << 5)); }
__host__ __device__ __forceinline__ void stage_rc(int b, int& R, int& C) { const int st = b / 1024, sb = b % 1024, swz = sb ^ (((sb >> 9) & 1) << 5); R = (st >> 1) * 16 + swz / 64; C = (st & 1) * 32 + (swz % 64) / 2; }
__host__ __device__ __forceinline__ int perm32(int rho) { const int n = rho >> 4, i = rho & 15; return 8 * (i >> 2) + 4 * n + (i & 3); }
struct Unit { int pm, pn, e; unsigned aoff, boff; };
struct Gemm { const char* A; const char* Bt; unsigned lda, ldb; int K; };

struct DenseOrder {
    int nM, nN, nwg, G, c; unsigned a256, b256;
    __device__ void init(int M, int N, int G_, int c_, unsigned lda, unsigned ldb) { nM = M / BM; nN = N / BM; nwg = nM * nN; G = G_; c = c_; a256 = 256u * lda; b256 = 256u * ldb; }
    __device__ bool next(int i, Unit& u) const {
        const long L = (long)i * G + c; if (L >= nwg) return false;
        int wgid = (int)L; { const int q = nwg / NXCD, r = nwg % NXCD, xcd = wgid % NXCD, off = wgid / NXCD; wgid = (xcd < r ? xcd * (q + 1) : r * (q + 1) + (xcd - r) * q) + off; }
        const int nig = WGM * nN, gid = wgid / nig, fm = gid * WGM, gsz = (nM - fm) < WGM ? (nM - fm) : WGM;
        u.pm = fm + ((wgid % nig) % gsz); u.pn = (wgid % nig) / gsz; u.e = 0; u.aoff = (unsigned)u.pm * a256; u.boff = (unsigned)u.pn * b256; return true;
    }
};
struct MoeOrder {
    const volatile LAS int* tstart; int nunits, G, c; unsigned a256, b256, bexp;
    __device__ bool next(int i, Unit& u) const {
        const int L = i * G + c; if (L >= nunits) return false;
        const int rt = L >> 2, j = L & 3; int e = 0;
        for (int k = 1; k < 32; ++k) e += (tstart[k] <= rt) ? 1 : 0;
        e = __builtin_amdgcn_readfirstlane(e);
        u.pm = rt; u.pn = j; u.e = e; u.aoff = (unsigned)rt * a256; u.boff = (unsigned)e * bexp + (unsigned)j * b256; return true;
    }
};

template <class Epi, class Sched, bool ALIGN_EPI>
__device__ __forceinline__ void gemm_phase(LAS unsigned char* lds, const Gemm g, const Sched& S, const Epi& E) {
    const int tid = threadIdx.x, wid = __builtin_amdgcn_readfirstlane(tid >> 6), lane = tid & 63, wr = wid >> 2, wc = wid & 3, fr = lane & 15, fq = lane >> 4;
    const int K = g.K, nt = K / BK;
    unsigned voffA[2], voffB[2];
#pragma unroll
    for (int i = 0; i < 2; ++i) { int R, C; stage_rc(tid * 16 + i * 8192, R, C); const int Rb = Epi::PERM ? ((R & ~31) + perm32(R & 31)) : R;
        voffA[i] = (unsigned)R * g.lda + (unsigned)C * 2u; voffB[i] = (unsigned)Rb * g.ldb + (unsigned)C * 2u; }
    const size_t kstep = (size_t)(BK * 2);
    const size_t hstepA = (size_t)HALF * g.lda, hstepB = (size_t)HALF * g.ldb;
    const unsigned ldsw = (unsigned)wid * 1024u;
    const int aoff = lds_byte(wr * 64 + fr, fq * 8), boff = lds_byte(wc * 32 + fr, fq * 8);
#define PG8_SA(b, h) (((b) * 2 + (h)) * HTB)
#define PG8_SB(b, h) ((4 + (b) * 2 + (h)) * HTB)
#define PG8_STAGE(bufoff, gbase, voff) do { _Pragma("unroll") for (int _i = 0; _i < 2; ++_i) \
        __builtin_amdgcn_global_load_lds((const unsigned*)((const char*)(gbase) + (voff)[_i]), (LAS unsigned*)(lds + (bufoff) + ldsw + _i * 8192), 16, 0, 0); } while (0)
#define PG8_LDA(dst, b, h) do { _Pragma("unroll") for (int m = 0; m < 4; ++m) _Pragma("unroll") for (int k = 0; k < 2; ++k) dst[m][k] = *(const LAS bf16x8*)(lds + PG8_SA(b, h) + aoff + m * 2048 + k * 1024); } while (0)
#define PG8_LDB(dst, b, h) do { _Pragma("unroll") for (int n = 0; n < 2; ++n) _Pragma("unroll") for (int k = 0; k < 2; ++k) dst[n][k] = *(const LAS bf16x8*)(lds + PG8_SB(b, h) + boff + n * 2048 + k * 1024); } while (0)
#define PG8_MMA(ai, bj, At, Bt) do { __builtin_amdgcn_s_setprio(1); _Pragma("unroll") for (int m = 0; m < 4; ++m) _Pragma("unroll") for (int n = 0; n < 2; ++n) _Pragma("unroll") for (int k = 0; k < 2; ++k) \
        acc[ai][bj][m][n] = __builtin_amdgcn_mfma_f32_16x16x32_bf16(Bt[n][k], At[m][k], acc[ai][bj][m][n], 0, 0, 0); __builtin_amdgcn_s_setprio(0); } while (0)
#define PG8_WAIT_V(n) asm volatile("s_waitcnt vmcnt(" #n ")" ::: "memory")
#define PG8_WAIT_L(n) asm volatile("s_waitcnt lgkmcnt(" #n ")" ::: "memory")
#define PG8_BAR __builtin_amdgcn_s_barrier()
#define PG8_SCHED __builtin_amdgcn_sched_barrier(0)
    Unit cur, nxt; int ui = 0;
    if (!S.next(0, cur)) return;
    f32x4 acc[2][2][4][2];
#pragma unroll
    for (int a = 0; a < 2; ++a)
#pragma unroll
        for (int b = 0; b < 2; ++b)
#pragma unroll
            for (int m = 0; m < 4; ++m)
#pragma unroll
                for (int n = 0; n < 2; ++n) acc[a][b][m][n] = (f32x4){0.f, 0.f, 0.f, 0.f};
    bf16x8 At[4][2], B0[2][2], B1[2][2];
    const char* cA = g.A + cur.aoff; const char* cB = g.Bt + cur.boff;
    PG8_STAGE(PG8_SB(0, 0), cB, voffB); PG8_STAGE(PG8_SB(0, 1), cB + hstepB, voffB); PG8_STAGE(PG8_SA(0, 0), cA, voffA); PG8_STAGE(PG8_SA(0, 1), cA + hstepA, voffA);
    if (wr == 1) PG8_BAR;
    PG8_WAIT_V(2); PG8_BAR;
    PG8_STAGE(PG8_SB(1, 0), cB + kstep, voffB); PG8_STAGE(PG8_SA(1, 0), cA + kstep, voffA); PG8_STAGE(PG8_SB(1, 1), cB + hstepB + kstep, voffB);
    PG8_WAIT_V(6); PG8_BAR;
    for (;;) {
        const bool has_next = S.next(ui + 1, nxt);
        const char* nA = has_next ? g.A + nxt.aoff : cA; const char* nB = has_next ? g.Bt + nxt.boff : cB;
        for (int t = 0; t < nt; t += 2) {
            const bool last = (t == nt - 2);
            const char* a1 = cA + (size_t)(t + 1) * kstep;
            const char* a2 = last ? nA : cA + (size_t)(t + 2) * kstep; const char* b2 = last ? nB : cB + (size_t)(t + 2) * kstep;
            const char* a3 = a2 + kstep; const char* b3 = b2 + kstep;
            PG8_LDB(B0, 0, 0); PG8_LDB(B1, 0, 1); PG8_SCHED; PG8_LDA(At, 0, 0); PG8_STAGE(PG8_SA(1, 1), a1 + hstepA, voffA);
            PG8_WAIT_V(8); PG8_WAIT_L(0); PG8_BAR; PG8_MMA(0, 0, At, B0); PG8_MMA(0, 1, At, B1); PG8_BAR; PG8_SCHED;
            PG8_LDA(At, 0, 1); PG8_STAGE(PG8_SB(0, 0), b2, voffB); PG8_STAGE(PG8_SB(0, 1), b2 + hstepB, voffB); PG8_STAGE(PG8_SA(0, 0), a2, voffA);
            PG8_WAIT_V(8); PG8_WAIT_L(0); PG8_BAR; PG8_MMA(1, 0, At, B0); PG8_MMA(1, 1, At, B1); PG8_BAR; PG8_SCHED;
            PG8_LDB(B0, 1, 0); PG8_LDB(B1, 1, 1); PG8_SCHED; PG8_LDA(At, 1, 0); PG8_STAGE(PG8_SA(0, 1), a2 + hstepA, voffA);
            PG8_WAIT_V(8); PG8_WAIT_L(0); PG8_BAR; PG8_MMA(0, 0, At, B0); PG8_MMA(0, 1, At, B1); PG8_BAR; PG8_SCHED;
            PG8_LDA(At, 1, 1); PG8_STAGE(PG8_SB(1, 0), b3, voffB); PG8_STAGE(PG8_SB(1, 1), b3 + hstepB, voffB); PG8_STAGE(PG8_SA(1, 0), a3, voffA);
            PG8_WAIT_V(8); PG8_WAIT_L(0); PG8_BAR; PG8_MMA(1, 0, At, B0); PG8_MMA(1, 1, At, B1); PG8_BAR; PG8_SCHED;
        }
        if constexpr (ALIGN_EPI) { if (wr == 0) PG8_BAR; }
        E(acc, cur, wr, wc, fr, fq);
        if (!has_next) break;
#pragma unroll
        for (int a = 0; a < 2; ++a)
#pragma unroll
            for (int b = 0; b < 2; ++b)
#pragma unroll
                for (int m = 0; m < 4; ++m)
#pragma unroll
                    for (int n = 0; n < 2; ++n) acc[a][b][m][n] = (f32x4){0.f, 0.f, 0.f, 0.f};
        cur = nxt; cA = nA; cB = nB; ++ui;
        if constexpr (ALIGN_EPI) { if (wr == 1) PG8_BAR; }
    }
    PG8_WAIT_V(0);
    if constexpr (!ALIGN_EPI) { if (wr == 0) PG8_BAR; }
    PG8_BAR;
#undef PG8_SA
#undef PG8_SB
#undef PG8_STAGE
#undef PG8_LDA
#undef PG8_LDB
#undef PG8_MMA
#undef PG8_WAIT_V
#undef PG8_WAIT_L
#undef PG8_BAR
#undef PG8_SCHED
}

struct EpiProj {
    static constexpr bool PERM = true;
    bf16_t* P; const float* qg; const float* kg;
    __device__ __forceinline__ void operator()(const f32x4 (&acc)[2][2][4][2], const Unit& u, int wr, int wc, int fr, int fq) const {
        const int ch = u.pn * 4 + wc, c0 = ch * 64;
        int kind = 0; const float* g = qg; float sc = 1.f;
        if (c0 < PC_FK) { kind = 1; g = qg + ch * 64; sc = C2; }
        else if (c0 < PC_FV) { kind = 1; g = kg + (ch - 8) * 64; }
        else if (c0 < PC_DQ) kind = 0;
        else if (c0 < PC_DK) { kind = 1; g = qg + (8 + ch - 24) * 64; sc = C2; }
        else if (c0 < PC_DV) { kind = 1; g = kg + (8 + ch - 36) * 64; }
        else if (c0 < PC_GA) kind = 0;
        else kind = 2;
        f32x4 gv[2][2];
#pragma unroll
        for (int bj = 0; bj < 2; ++bj)
#pragma unroll
            for (int n = 0; n < 2; ++n) gv[bj][n] = (kind == 1) ? *(const f32x4*)(g + 32 * bj + 8 * fq + 4 * n) : (f32x4){1.f, 1.f, 1.f, 1.f};
        const int row0 = u.pm * BM + wr * 64 + fr;
#pragma unroll
        for (int ai = 0; ai < 2; ++ai)
#pragma unroll
            for (int m = 0; m < 4; ++m) {
                f32x4 v[2][2];
#pragma unroll
                for (int bj = 0; bj < 2; ++bj)
#pragma unroll
                    for (int n = 0; n < 2; ++n) v[bj][n] = acc[ai][bj][m][n];
                if (kind == 1) {
                    float ss = 0.f;
#pragma unroll
                    for (int bj = 0; bj < 2; ++bj)
#pragma unroll
                        for (int n = 0; n < 2; ++n) ss += (v[bj][n][0] * v[bj][n][0] + v[bj][n][1] * v[bj][n][1]) + (v[bj][n][2] * v[bj][n][2] + v[bj][n][3] * v[bj][n][3]);
                    ss += __shfl_xor(ss, 16); ss += __shfl_xor(ss, 32);
                    const float r = rsqrtf(ss * (1.f / 64.f) + EPS_) * sc;
#pragma unroll
                    for (int bj = 0; bj < 2; ++bj)
#pragma unroll
                        for (int n = 0; n < 2; ++n) v[bj][n] = v[bj][n] * r * gv[bj][n];
                } else if (kind == 2) {
#pragma unroll
                    for (int bj = 0; bj < 2; ++bj)
#pragma unroll
                        for (int n = 0; n < 2; ++n)
#pragma unroll
                            for (int j = 0; j < 4; ++j) v[bj][n][j] = __builtin_amdgcn_rcpf(1.f + __builtin_amdgcn_exp2f(-LOG2E * v[bj][n][j]));
                }
                bf16_t* rowp = P + (size_t)(row0 + ai * HALF + m * 16) * NP + c0 + 8 * fq;
#pragma unroll
                for (int bj = 0; bj < 2; ++bj) { u32x4 w; w.x = pk2(v[bj][0][0], v[bj][0][1]); w.y = pk2(v[bj][0][2], v[bj][0][3]); w.z = pk2(v[bj][1][0], v[bj][1][1]); w.w = pk2(v[bj][1][2], v[bj][1][3]);
                    *(u32x4*)(rowp + 32 * bj) = w; }
            }
    }
};
__device__ __forceinline__ void unpack8(const u32x4 w, float (&f)[8]) {
    f[0] = __uint_as_float(w.x << 16); f[1] = __uint_as_float(w.x & 0xffff0000u); f[2] = __uint_as_float(w.y << 16); f[3] = __uint_as_float(w.y & 0xffff0000u);
    f[4] = __uint_as_float(w.z << 16); f[5] = __uint_as_float(w.z & 0xffff0000u); f[6] = __uint_as_float(w.w << 16); f[7] = __uint_as_float(w.w & 0xffff0000u);
}
template <int MODE> struct EpiBranch {
    static constexpr bool PERM = true;
    bf16_t* MG; const bf16_t* P;
    __device__ __forceinline__ void operator()(const f32x4 (&acc)[2][2][4][2], const Unit& u, int wr, int wc, int fr, int fq) const {
        const int row0 = u.pm * BM + wr * 64 + fr, col0 = u.pn * BM + wc * 32 + 8 * fq;
#pragma unroll
        for (int ai = 0; ai < 2; ++ai)
#pragma unroll
            for (int m = 0; m < 4; ++m) { const size_t row = (size_t)(row0 + ai * HALF + m * 16);
#pragma unroll
                for (int bj = 0; bj < 2; ++bj) { const int col = col0 + bj * HALF;
                    float gt[8]; unpack8(*(const u32x4*)(P + row * NP + (MODE == 0 ? PC_GA : PC_GB) + col), gt);
                    f32x4 v0 = acc[ai][bj][m][0], v1 = acc[ai][bj][m][1];
                    float o[8] = {v0[0] * gt[0], v0[1] * gt[1], v0[2] * gt[2], v0[3] * gt[3], v1[0] * gt[4], v1[1] * gt[5], v1[2] * gt[6], v1[3] * gt[7]};
                    if (MODE == 1) { float pv[8]; unpack8(*(const u32x4*)(MG + row * D_ + col), pv);
#pragma unroll
                        for (int j = 0; j < 8; ++j) o[j] += pv[j]; }
                    u32x4 w; w.x = pk2(o[0], o[1]); w.y = pk2(o[2], o[3]); w.z = pk2(o[4], o[5]); w.w = pk2(o[6], o[7]);
                    *(u32x4*)(MG + row * D_ + col) = w; } }
    }
};
struct EpiOut {
    static constexpr bool PERM = false;
    float* x1; const float* x; const float* mod;
    __device__ __forceinline__ void operator()(const f32x4 (&acc)[2][2][4][2], const Unit& u, int wr, int wc, int fr, int fq) const {
        const int row0 = u.pm * BM + wr * 64 + fr, col0 = u.pn * BM + wc * 32 + 4 * fq;
        const float* g1 = mod + (u.pm >> 3) * 6144 + 2048;
        f32x4 gv[2][2];
#pragma unroll
        for (int bj = 0; bj < 2; ++bj)
#pragma unroll
            for (int n = 0; n < 2; ++n) gv[bj][n] = *(const f32x4*)(g1 + col0 + bj * HALF + n * 16);
#pragma unroll
        for (int ai = 0; ai < 2; ++ai)
#pragma unroll
            for (int m = 0; m < 4; ++m) { const size_t ro = (size_t)(row0 + ai * HALF + m * 16) * D_ + col0;
#pragma unroll
                for (int bj = 0; bj < 2; ++bj)
#pragma unroll
                    for (int n = 0; n < 2; ++n) { const f32x4 xv = *(const f32x4*)(x + ro + bj * HALF + n * 16);
                        *(f32x4*)(x1 + ro + bj * HALF + n * 16) = xv + gv[bj][n] * acc[ai][bj][m][n]; } }
    }
};
struct EpiGateUp {
    static constexpr bool PERM = true;
    bf16_t* HID;
    __device__ __forceinline__ void operator()(const f32x4 (&acc)[2][2][4][2], const Unit& u, int wr, int wc, int fr, int fq) const {
        const int row0 = u.pm * BM + wr * 64 + fr, col0 = u.pn * 128 + wc * 32 + 8 * fq;
#pragma unroll
        for (int ai = 0; ai < 2; ++ai)
#pragma unroll
            for (int m = 0; m < 4; ++m) { float o[8];
#pragma unroll
                for (int n = 0; n < 2; ++n)
#pragma unroll
                    for (int j = 0; j < 4; ++j) { const float a = acc[ai][0][m][n][j], up = acc[ai][1][m][n][j];
                        o[n * 4 + j] = a * __builtin_amdgcn_rcpf(1.f + __builtin_amdgcn_exp2f(-LOG2E * a)) * up; }
                u32x4 w; w.x = pk2(o[0], o[1]); w.y = pk2(o[2], o[3]); w.z = pk2(o[4], o[5]); w.w = pk2(o[6], o[7]);
                *(u32x4*)(HID + (size_t)(row0 + ai * HALF + m * 16) * EH + col0) = w; }
    }
};
struct EpiBf16 {
    static constexpr bool PERM = true;
    bf16_t* O; int ldc;
    __device__ __forceinline__ void operator()(const f32x4 (&acc)[2][2][4][2], const Unit& u, int wr, int wc, int fr, int fq) const {
        const int row0 = u.pm * BM + wr * 64 + fr, col0 = u.pn * BM + wc * 32 + 8 * fq;
#pragma unroll
        for (int ai = 0; ai < 2; ++ai)
#pragma unroll
            for (int m = 0; m < 4; ++m) { bf16_t* rowp = O + (size_t)(row0 + ai * HALF + m * 16) * ldc + col0;
#pragma unroll
                for (int bj = 0; bj < 2; ++bj) { const f32x4 v0 = acc[ai][bj][m][0], v1 = acc[ai][bj][m][1];
                    u32x4 w; w.x = pk2(v0[0], v0[1]); w.y = pk2(v0[2], v0[3]); w.z = pk2(v1[0], v1[1]); w.w = pk2(v1[2], v1[3]);
                    *(u32x4*)(rowp + bj * HALF) = w; } }
    }
};
}
struct Frame {
    LAS unsigned char* lds; unsigned char* ldsg;
    int tid, lane, wave, vcu, G;
    const float* const* in; float* out; unsigned char* ws;
};
#define FIN(k) (F.in[k])

__device__ __forceinline__ void p0_mod(Frame& F) {
    LAS float* sil = (LAS float*)F.lds;
    LAS float* red = (LAS float*)(F.lds + 32768);
    for (int i = F.tid; i < 8 * D_; i += NTHR) sil[i] = silu_f(FIN(I_C)[i]);
    __syncthreads();
    float* mod = (float*)(F.ws + WS_MOD);
    const int c = F.lane & 31, kp = F.lane >> 5;
    for (int slice = F.vcu; slice < 256; slice += F.G) {
        const int col0 = slice * 24;
        float acc[8] = {0.f, 0.f, 0.f, 0.f, 0.f, 0.f, 0.f, 0.f};
        const float* wp = FIN(I_WADA) + (size_t)(128 * F.wave + kp) * 6144 + col0 + (c < 24 ? c : 0);
#pragma unroll 8
        for (int i = 0; i < 64; ++i) { const float wv = wp[(size_t)(2 * i) * 6144]; const int k = 128 * F.wave + kp + 2 * i;
#pragma unroll
            for (int b = 0; b < 8; ++b) acc[b] += sil[b * D_ + k] * wv; }
#pragma unroll
        for (int b = 0; b < 8; ++b) { acc[b] += __shfl_xor(acc[b], 32); if (F.lane < 24) red[(F.wave * 8 + b) * 24 + c] = acc[b]; }
        __syncthreads();
        if (F.tid < 192) { const int b = F.tid / 24, cc = F.tid % 24; float s = FIN(I_BADA)[col0 + cc];
#pragma unroll
            for (int w = 0; w < 8; ++w) s += red[(w * 8 + b) * 24 + cc];
            mod[b * 6144 + col0 + cc] = s; }
        __syncthreads();
    }
}
__device__ __forceinline__ void transpose_item(const float* src, int ldw, bf16_t* dst, int ldk, LAS float* scr, int lane) {
#pragma unroll 8
    for (int i = 0; i < 32; ++i) { const int kk = 2 * i + (lane >> 5); scr[kk * 33 + (lane & 31)] = src[(size_t)kk * ldw + (lane & 31)]; }
    LDS_WAIT(); asm volatile("" ::: "memory");
    const int c = lane & 7;
#pragma unroll
    for (int j = 0; j < 4; ++j) { const int n = (lane >> 3) + 8 * j; const LAS float* s = scr + (8 * c) * 33 + n;
        u32x4 o; o.x = pk2(s[0 * 33], s[1 * 33]); o.y = pk2(s[2 * 33], s[3 * 33]); o.z = pk2(s[4 * 33], s[5 * 33]); o.w = pk2(s[6 * 33], s[7 * 33]);
        *(u32x4*)(dst + (size_t)n * ldk + 8 * c) = o; }
    LDS_WAIT(); asm volatile("" ::: "memory");
}
__device__ __forceinline__ void p0_prologue(Frame& F) {
    LAS float* scr = (LAS float*)(F.lds + F.wave * 16384);
    const int gw = F.vcu * NWAVES + F.wave, NGW = F.G * NWAVES;
    p0_mod(F);
    constexpr int I_MOD = 0, I_WINB = 16 * 184, I_A = 8 * 32, I_B = 4 * 32, I_O = 16 * 32, NITEMS = I_MOD + I_WINB + I_A + I_B + I_O;
    for (int it = gw; it < NITEMS; it += NGW) {
        int r = it;
        if (r < I_WINB) { const int kb = r / 184, pcb = r % 184, pc0 = pcb * 32, sc0 = pc0 < SRC_FORGET ? pc0 : pc0 + 8;
            const int tile = pc0 >> 8, within = pc0 & 255, wc = within >> 6, bj = (within >> 5) & 1, row0 = tile * 256 + 128 * bj + 32 * wc;
            transpose_item(FIN(I_WIN) + (size_t)(64 * kb) * NIN + sc0, NIN, (bf16_t*)(F.ws + WS_WIN) + (size_t)row0 * D_ + 64 * kb, D_, scr, F.lane); continue; } r -= I_WINB;
        if (r < I_A) { const int kb = r / 32, nb = r % 32; transpose_item(FIN(I_WBA) + (size_t)(64 * kb) * D_ + 32 * nb, D_, (bf16_t*)(F.ws + WS_WA) + (size_t)(32 * nb) * 512 + 64 * kb, 512, scr, F.lane); continue; } r -= I_A;
        if (r < I_B) { const int kb = r / 32, nb = r % 32; transpose_item(FIN(I_WBB) + (size_t)(64 * kb) * D_ + 32 * nb, D_, (bf16_t*)(F.ws + WS_WB) + (size_t)(32 * nb) * 256 + 64 * kb, 256, scr, F.lane); continue; } r -= I_B;
        { const int kb = r / 32, nb = r % 32; transpose_item(FIN(I_WOUT) + (size_t)(64 * kb) * D_ + 32 * nb, D_, (bf16_t*)(F.ws + WS_WOUT) + (size_t)(32 * nb) * D_ + 64 * kb, D_, scr, F.lane); }
    }
}
__device__ __forceinline__ void p1_norm1(Frame& F) {
    LAS float* wf = (LAS float*)F.lds;
    for (int i = F.tid; i < 8 * D_; i += NTHR) { const int c = i >> 3, hh = i & 7; wf[hh * D_ + c] = FIN(I_WIN)[(size_t)c * NIN + SRC_FORGET + hh]; }
    __syncthreads();
    const int gw = F.vcu * NWAVES + F.wave, t0 = gw * 8, b = t0 / S_;
    const float* mod = (const float*)(F.ws + WS_MOD) + b * 6144;
    f32x4 gsc[4], shv[4];
#pragma unroll
    for (int j = 0; j < 4; ++j) { const int c = 4 * F.lane + 256 * j; const f32x4 g = *(const f32x4*)(FIN(I_N1G) + c), sc = *(const f32x4*)(mod + 1024 + c); gsc[j] = g * (sc + 1.f); shv[j] = *(const f32x4*)(mod + c); }
    bf16_t* H = (bf16_t*)(F.ws + WS_H); float* logf = (float*)(F.ws + WS_LOGF);
    for (int tt = 0; tt < 8; ++tt) { const int t = t0 + tt;
        f32x4 v[4]; float ss = 0.f;
#pragma unroll
        for (int j = 0; j < 4; ++j) { v[j] = *(const f32x4*)(FIN(I_X) + (size_t)t * D_ + 4 * F.lane + 256 * j); ss += (v[j][0] * v[j][0] + v[j][1] * v[j][1]) + (v[j][2] * v[j][2] + v[j][3] * v[j][3]); }
        const float rstd = rsqrtf(wave_sum(ss) * (1.f / D_) + EPS_);
        float z[8] = {0.f, 0.f, 0.f, 0.f, 0.f, 0.f, 0.f, 0.f};
#pragma unroll
        for (int j = 0; j < 4; ++j) { v[j] = v[j] * rstd * gsc[j] + shv[j];
            u32x2 o; o.x = pk2(v[j][0], v[j][1]); o.y = pk2(v[j][2], v[j][3]);
            *(u32x2*)(H + (size_t)t * D_ + 4 * F.lane + 256 * j) = o;
#pragma unroll
            for (int hh = 0; hh < 8; ++hh) { const f32x4 w = *(const LAS f32x4*)(wf + hh * D_ + 4 * F.lane + 256 * j); z[hh] += (v[j][0] * w[0] + v[j][1] * w[1]) + (v[j][2] * w[2] + v[j][3] * w[3]); } }
#pragma unroll
        for (int hh = 0; hh < 8; ++hh) z[hh] = wave_sum(z[hh]);
        if (F.lane < 8) { float zz = z[0];
#pragma unroll
            for (int hh = 1; hh < 8; ++hh) zz = (F.lane == hh) ? z[hh] : zz;
            zz += FIN(I_BFORGET)[F.lane];
            logf[((size_t)b * 8 + F.lane) * S_ + (t - b * S_)] = fminf(zz, 0.f) - log1pf(__expf(-fabsf(zz))); }
    }
    __syncthreads();
}
__device__ __forceinline__ int crow(int r, int hi) { return (r & 3) + 8 * (r >> 2) + 4 * hi; }
typedef short v4i16_t __attribute__((ext_vector_type(4)));
__device__ __forceinline__ s16x4 vtr(const LAS unsigned char* p) { return __builtin_bit_cast(s16x4, __builtin_amdgcn_ds_read_tr16_b64_v4i16((LAS v4i16_t*)p)); }
__device__ __forceinline__ float half_swap_max(float m) { auto rr = __builtin_amdgcn_permlane32_swap(__float_as_uint(m), __float_as_uint(m), false, false); return fmaxf(__uint_as_float(rr[0]), __uint_as_float(rr[1])); }
__device__ __forceinline__ float half_swap_sum(float m) { auto rr = __builtin_amdgcn_permlane32_swap(__float_as_uint(m), __float_as_uint(m), false, false); return __uint_as_float(rr[0]) + __uint_as_float(rr[1]); }
__device__ __forceinline__ int vimg(int key, int cbyte) { return key * 128 + (cbyte ^ (((key >> 1) & 1) << 6)); }
__device__ __forceinline__ void pv_step(f32x16& o0, f32x16& o1, const LAS unsigned char* vrow16, int lane, bf16x8 pb) {
    const int hi = lane >> 5, i = lane & 15, g1 = (lane >> 4) & 1;
    const int kq = 4 * hi + (i >> 2);
    const int sw = ((kq >> 1) & 1) << 6;
    const int c0 = (32 * g1 + 8 * (i & 3));
    const LAS unsigned char* p0 = vrow16 + kq * 128;
    const s16x4 a0lo = vtr(p0 + ((c0) ^ sw)), a0hi = vtr(p0 + 8 * 128 + ((c0) ^ sw));
    const s16x4 a1lo = vtr(p0 + ((c0 + 64) ^ sw)), a1hi = vtr(p0 + 8 * 128 + ((c0 + 64) ^ sw));
    const bf16x8 A0 = {a0lo[0], a0lo[1], a0lo[2], a0lo[3], a0hi[0], a0hi[1], a0hi[2], a0hi[3]};
    const bf16x8 A1 = {a1lo[0], a1lo[1], a1lo[2], a1lo[3], a1hi[0], a1hi[1], a1hi[2], a1hi[3]};
    o0 = __builtin_amdgcn_mfma_f32_32x32x16_bf16(A0, pb, o0, 0, 0, 0);
    o1 = __builtin_amdgcn_mfma_f32_32x32x16_bf16(A1, pb, o1, 0, 0, 0);
}
__device__ __forceinline__ bf16x8 pack8(const f32x16& p, int b) {
    u32x4 w; w.x = pk2(p[b], p[b + 1]); w.y = pk2(p[b + 2], p[b + 3]); w.z = pk2(p[b + 4], p[b + 5]); w.w = pk2(p[b + 6], p[b + 7]);
    return __builtin_bit_cast(bf16x8, w);
}
__device__ __forceinline__ void store_ot(bf16_t* dst, const f32x16& o0, const f32x16& o1, float rl, int hi) {
#pragma unroll
    for (int i = 0; i < 4; ++i) {
        u32x2 a; a.x = pk2(o0[4 * i] * rl, o0[4 * i + 1] * rl); a.y = pk2(o0[4 * i + 2] * rl, o0[4 * i + 3] * rl);
        u32x2 b; b.x = pk2(o1[4 * i] * rl, o1[4 * i + 1] * rl); b.y = pk2(o1[4 * i + 2] * rl, o1[4 * i + 3] * rl);
        *(u32x2*)(dst + 8 * i + 4 * hi) = a; *(u32x2*)(dst + 32 + 8 * i + 4 * hi) = b; }
}

constexpr int DIL_TBL_OFF = 8 * 4096;
constexpr float NEG_BIG = -30000.f;
__device__ __forceinline__ void p3a_dilated(Frame& F) {
    LAS float* tbl = (LAS float*)(F.lds + DIL_TBL_OFF);
    for (int i = F.tid; i < 12 * 192; i += NTHR) { const int hd = i / 192, x = i % 192, m = 159 - x, g = hd >> 2, d = (g == 0) ? 1 : (g == 1 ? 4 : 16); (void)d;
        tbl[i] = (m >= 0 && m <= 128) ? FIN(I_TABLE)[T5BUCKET[g][m] * 12 + hd] * LOG2E : NEG_BIG; }
    __syncthreads();
    const bf16_t* P = (const bf16_t*)(F.ws + WS_PROJ);
    bf16_t* OG = (bf16_t*)(F.ws + WS_OG); float* LSE = (float*)(F.ws + WS_LSE);
    LAS unsigned char* vbuf = F.lds + F.wave * 4096;
    const int lane = F.lane, r32 = lane & 31, hi = lane >> 5;
    for (int unit = F.vcu; unit < 768; unit += F.G) {
        const int task = unit * 8 + F.wave, bh = task >> 6, j = task & 63, b = bh / 12, hd = bh % 12, g = hd >> 2, slot = hd & 3;
        int d, r, qt;
        if (g == 0) { d = 1; r = 0; qt = j; } else if (g == 1) { d = 4; r = j >> 4; qt = j & 15; } else { d = 16; r = j >> 2; qt = j & 3; }
        const size_t rowb = (size_t)b * S_;
        const int n0 = 32 * qt;
        const bf16_t* qrow = P + (rowb + (size_t)(n0 + r32) * d + r) * NP + PC_DQ + hd * 64 + 8 * hi;
        bf16x8 qf[4];
#pragma unroll
        for (int s = 0; s < 4; ++s) qf[s] = *(const bf16x8*)(qrow + 16 * s);
        float m_run = -1e30f, l_run = 0.f; f32x16 o0 = {}, o1 = {};
        const LAS float* tb = tbl + hd * 192;
        for (int kt = qt; kt >= 0 && kt >= qt - 4; --kt) {
            const int k0 = 32 * kt;
            const bf16_t* krow = P + (rowb + (size_t)(k0 + r32) * d + r) * NP + PC_DK + hd * 64 + 8 * hi;
            bf16x8 kf[4];
#pragma unroll
            for (int s = 0; s < 4; ++s) kf[s] = *(const bf16x8*)(krow + 16 * s);
            u32x4 vr[4];
#pragma unroll
            for (int i = 0; i < 4; ++i) { const int row = (lane >> 3) + 8 * i; vr[i] = *(const u32x4*)(P + (rowb + (size_t)(k0 + row) * d + r) * NP + PC_DV + hd * 64 + (lane & 7) * 8); }
            f32x16 sc = {};
#pragma unroll
            for (int s = 0; s < 4; ++s) sc = __builtin_amdgcn_mfma_f32_32x32x16_bf16(kf[s], qf[s], sc, 0, 0, 0);
            const LAS float* tp = tb + (159 - 32 * (qt - kt) - r32 + 4 * hi);
            float mx = -1e30f;
#pragma unroll
            for (int rg = 0; rg < 16; ++rg) { sc[rg] += tp[(rg & 3) + 8 * (rg >> 2)]; mx = fmaxf(mx, sc[rg]); }
            mx = half_swap_max(mx);
            const float mn = fmaxf(m_run, mx), alpha = __builtin_amdgcn_exp2f(m_run - mn); m_run = mn;
            float ls = 0.f;
#pragma unroll
            for (int rg = 0; rg < 16; ++rg) { sc[rg] = __builtin_amdgcn_exp2f(sc[rg] - mn); ls += sc[rg]; }
            l_run = l_run * alpha + ls;
#pragma unroll
            for (int rg = 0; rg < 16; ++rg) { o0[rg] *= alpha; o1[rg] *= alpha; }
            const bf16x8 pb0 = pack8(sc, 0), pb1 = pack8(sc, 8);
#pragma unroll
            for (int i = 0; i < 4; ++i) { const int row = (lane >> 3) + 8 * i; *(LAS u32x4*)(vbuf + vimg(row, (lane & 7) * 16)) = vr[i]; }
            LDS_WAIT(); asm volatile("" ::: "memory");
            pv_step(o0, o1, vbuf, lane, pb0);
            pv_step(o0, o1, vbuf + 16 * 128, lane, pb1);
            LDS_WAIT(); asm volatile("" ::: "memory");
        }
        const float lt = half_swap_sum(l_run), rl = __builtin_amdgcn_rcpf(lt);
        const size_t tok = rowb + (size_t)(n0 + r32) * d + r;
        store_ot(OG + ((size_t)g * T_ + tok) * 256 + slot * 64, o0, o1, rl, hi);
        if (hi == 0) LSE[((size_t)g * T_ + tok) * 4 + slot] = m_run + __builtin_amdgcn_logf(lt);
    }
    __syncthreads();
}

constexpr int FOX_K_OFF = 0, FOX_V_OFF = 16384, FOX_CUM_OFF = 32768;
__device__ __forceinline__ int kimg(int key, int chunk) { return key * 128 + ((chunk ^ ((key >> 1) & 7)) << 4); }
__device__ __forceinline__ void fox_unit(Frame& F, int b, int h, int qb) {
    const bf16_t* P = (const bf16_t*)(F.ws + WS_PROJ);
    const float* logf = (const float*)(F.ws + WS_LOGF) + ((size_t)b * 8 + h) * S_;
    LAS float* ncum = (LAS float*)(F.lds + FOX_CUM_OFF);
    const int lane = F.lane, r32 = lane & 31, hi = lane >> 5, tid = F.tid;
    const int nkeys = 256 * (qb + 1), nt = nkeys / 64;
    if (F.wave == 0) {
        const int per = nkeys / 64; float run = 0.f; float loc[32];
#pragma unroll
        for (int i = 0; i < 32; ++i) { const float v = (i < per) ? logf[lane * per + i] : 0.f; run += v; loc[i] = run; }
        float incl = run;
#pragma unroll
        for (int o = 1; o < 64; o <<= 1) { const float t = __shfl_up(incl, o); if (lane >= o) incl += t; }
        const float base = incl - run;
#pragma unroll
        for (int i = 0; i < 32; ++i) if (i < per) ncum[lane * per + i] = -(base + loc[i]) * LOG2E;
    }
    const size_t rowb = (size_t)b * S_;
    const int srow = tid >> 3, sch = tid & 7;
    const bf16_t* kg = P + (rowb + srow) * NP + PC_FK + h * 64 + sch * 8;
    const bf16_t* vg = P + (rowb + srow) * NP + PC_FV + h * 64 + sch * 8;
    u32x4 kst = *(const u32x4*)kg, vst = *(const u32x4*)vg;
    const int q0w = qb * 256 + F.wave * 32;
    const bf16_t* qrow = P + (rowb + q0w + r32) * NP + PC_FQ + h * 64 + 8 * hi;
    bf16x8 qf[4];
#pragma unroll
    for (int s = 0; s < 4; ++s) qf[s] = *(const bf16x8*)(qrow + 16 * s);
    *(LAS u32x4*)(F.lds + FOX_K_OFF + kimg(srow, sch)) = kst;
    *(LAS u32x4*)(F.lds + FOX_V_OFF + vimg(srow, sch * 16)) = vst;
    __syncthreads();
    float m_run = -1e30f, l_run = 0.f; f32x16 o0 = {}, o1 = {};
    for (int t = 0; t < nt; ++t) {
        const int cur = t & 1;
        if (t + 1 < nt) { kst = *(const u32x4*)(kg + (size_t)(t + 1) * 64 * NP); vst = *(const u32x4*)(vg + (size_t)(t + 1) * 64 * NP); }
        const int k0 = 64 * t;
        if (k0 <= q0w + 31) {
            const LAS unsigned char* kb = F.lds + FOX_K_OFF + cur * 8192;
            const LAS unsigned char* vb = F.lds + FOX_V_OFF + cur * 8192;
            f32x16 s0 = {}, s1 = {};
#pragma unroll
            for (int s = 0; s < 4; ++s) {
                const bf16x8 ka = *(const LAS bf16x8*)(kb + kimg(r32, 2 * s + hi));
                const bf16x8 kc = *(const LAS bf16x8*)(kb + kimg(32 + r32, 2 * s + hi));
                s0 = __builtin_amdgcn_mfma_f32_32x32x16_bf16(ka, qf[s], s0, 0, 0, 0);
                s1 = __builtin_amdgcn_mfma_f32_32x32x16_bf16(kc, qf[s], s1, 0, 0, 0);
            }
            const LAS float* nc = ncum + k0 + 4 * hi;
#pragma unroll
            for (int i = 0; i < 4; ++i) { const f32x4 c0 = *(const LAS f32x4*)(nc + 8 * i), c1 = *(const LAS f32x4*)(nc + 32 + 8 * i);
#pragma unroll
                for (int jj = 0; jj < 4; ++jj) { s0[4 * i + jj] += c0[jj]; s1[4 * i + jj] += c1[jj]; } }
            if (k0 + 63 > q0w) {
                const int q = q0w + r32;
#pragma unroll
                for (int rg = 0; rg < 16; ++rg) { const int key = k0 + crow(rg, hi); if (key > q) s0[rg] = -1e30f; if (key + 32 > q) s1[rg] = -1e30f; }
            }
            float mx = -1e30f;
#pragma unroll
            for (int rg = 0; rg < 16; ++rg) mx = fmaxf(mx, fmaxf(s0[rg], s1[rg]));
            mx = half_swap_max(mx);
            const float mn = fmaxf(m_run, mx), alpha = __builtin_amdgcn_exp2f(m_run - mn); m_run = mn;
            float ls = 0.f;
#pragma unroll
            for (int rg = 0; rg < 16; ++rg) { s0[rg] = __builtin_amdgcn_exp2f(s0[rg] - mn); s1[rg] = __builtin_amdgcn_exp2f(s1[rg] - mn); ls += s0[rg] + s1[rg]; }
            l_run = l_run * alpha + ls;
#pragma unroll
            for (int rg = 0; rg < 16; ++rg) { o0[rg] *= alpha; o1[rg] *= alpha; }
            pv_step(o0, o1, vb, lane, pack8(s0, 0));
            pv_step(o0, o1, vb + 16 * 128, lane, pack8(s0, 8));
            pv_step(o0, o1, vb + 32 * 128, lane, pack8(s1, 0));
            pv_step(o0, o1, vb + 48 * 128, lane, pack8(s1, 8));
        }
        if (t + 1 < nt) {
            *(LAS u32x4*)(F.lds + FOX_K_OFF + (cur ^ 1) * 8192 + kimg(srow, sch)) = kst;
            *(LAS u32x4*)(F.lds + FOX_V_OFF + (cur ^ 1) * 8192 + vimg(srow, sch * 16)) = vst;
        }
        __syncthreads();
    }
    const float lt = half_swap_sum(l_run), rl = __builtin_amdgcn_rcpf(lt);
    store_ot((bf16_t*)(F.ws + WS_YA) + (rowb + q0w + r32) * 512 + h * 64, o0, o1, rl, hi);
}
__device__ __forceinline__ void combine_token(Frame& F, int t) {
    const bf16_t* OG = (const bf16_t*)(F.ws + WS_OG); const float* LSE = (const float*)(F.ws + WS_LSE);
    const int c = 4 * F.lane, slot = F.lane >> 4;
    float l0 = LSE[((size_t)0 * T_ + t) * 4 + slot], l1 = LSE[((size_t)1 * T_ + t) * 4 + slot], l2 = LSE[((size_t)2 * T_ + t) * 4 + slot];
    const float mx = fmaxf(l0, fmaxf(l1, l2)); l0 = __builtin_amdgcn_exp2f(l0 - mx); l1 = __builtin_amdgcn_exp2f(l1 - mx); l2 = __builtin_amdgcn_exp2f(l2 - mx);
    const float r = __builtin_amdgcn_rcpf(l0 + l1 + l2); l0 *= r; l1 *= r; l2 *= r;
    const u32x2 a = *(const u32x2*)(OG + ((size_t)0 * T_ + t) * 256 + c), bq = *(const u32x2*)(OG + ((size_t)1 * T_ + t) * 256 + c), cq = *(const u32x2*)(OG + ((size_t)2 * T_ + t) * 256 + c);
    auto lo = [](unsigned w) { return __uint_as_float(w << 16); }; auto hi16 = [](unsigned w) { return __uint_as_float(w & 0xffff0000u); };
    u32x2 o;
    o.x = pk2(l0 * lo(a.x) + l1 * lo(bq.x) + l2 * lo(cq.x), l0 * hi16(a.x) + l1 * hi16(bq.x) + l2 * hi16(cq.x));
    o.y = pk2(l0 * lo(a.y) + l1 * lo(bq.y) + l2 * lo(cq.y), l0 * hi16(a.y) + l1 * hi16(bq.y) + l2 * hi16(cq.y));
    *(u32x2*)((bf16_t*)(F.ws + WS_YD) + (size_t)t * 256 + c) = o;
}
__device__ __forceinline__ void p3b_fox(Frame& F) {
    for (int u = F.vcu; u < 256; u += F.G) {
        const int bh = u >> 2, p = u & 3;
        fox_unit(F, bh >> 3, bh & 7, 7 - p);
        fox_unit(F, bh >> 3, bh & 7, p);
    }
    const int gw = F.vcu * NWAVES + F.wave, NGW = F.G * NWAVES;
    for (int t = gw; t < T_; t += NGW) combine_token(F, t);
}
__device__ __forceinline__ void p7_norm2_router(Frame& F) {
    volatile LAS unsigned* LC = (volatile LAS unsigned*)(F.lds + LDS_CTL);
    {   LAS float* scr = (LAS float*)(F.lds + F.wave * 16384);
        const int gw = F.vcu * NWAVES + F.wave, NGW = F.G * NWAVES;
        for (int it = gw; it < 24576; it += NGW) {
            if (it < 16384) { const int e = it >> 9, r = it & 511, mat = r >> 8, r2 = r & 255, kb = r2 >> 4, nb = r2 & 15, hc0 = 32 * nb, row = (hc0 >> 7) * 256 + mat * 128 + (hc0 & 127);
                transpose_item(FIN(mat ? I_W3 : I_W1) + (size_t)e * D_ * EH + (size_t)(64 * kb) * EH + hc0, EH, (bf16_t*)(F.ws + WS_W13) + ((size_t)e * 1024 + row) * D_ + 64 * kb, D_, scr, F.lane); }
            else { const int r = it - 16384, e = r >> 8, r2 = r & 255, kb = r2 >> 5, nb = r2 & 31;
                transpose_item(FIN(I_W2) + (size_t)e * EH * D_ + (size_t)(64 * kb) * D_ + 32 * nb, D_, (bf16_t*)(F.ws + WS_W2T) + ((size_t)e * 1024 + 32 * nb) * EH + 64 * kb, EH, scr, F.lane); }
        }
    }
    __syncthreads();
    LAS float* wT = (LAS float*)F.lds;
    for (int i = F.tid; i < 36 * D_; i += NTHR) { const int e = i >> 10, c = i & 1023; wT[i] = (e < 4) ? FIN(I_WRG)[c * 4 + e] : FIN(I_WRE)[c * 32 + e - 4]; }
    if (F.tid < 32) LC[LC_CNT + F.tid] = 0u;
    __syncthreads();
    const int gw = F.vcu * NWAVES + F.wave, t0 = gw * 8, b = t0 / S_;
    const float* mod = (const float*)(F.ws + WS_MOD) + b * 6144;
    f32x4 gsc[4], shv[4];
#pragma unroll
    for (int j = 0; j < 4; ++j) { const int c = 4 * F.lane + 256 * j; const f32x4 g = *(const f32x4*)(FIN(I_N2G) + c), sc = *(const f32x4*)(mod + 4096 + c); gsc[j] = g * (sc + 1.f); shv[j] = *(const f32x4*)(mod + 3072 + c); }
    bf16_t* H2 = (bf16_t*)(F.ws + WS_H); int* toke = (int*)(F.ws + WS_TOKE); float* tokw = (float*)(F.ws + WS_TOKW);
    for (int tt = 0; tt < 8; ++tt) { const int t = t0 + tt;
        f32x4 v[4]; float ss = 0.f;
#pragma unroll
        for (int j = 0; j < 4; ++j) { v[j] = *(const f32x4*)(F.out + (size_t)t * D_ + 4 * F.lane + 256 * j); ss += (v[j][0] * v[j][0] + v[j][1] * v[j][1]) + (v[j][2] * v[j][2] + v[j][3] * v[j][3]); }
        const float rstd = rsqrtf(wave_sum(ss) * (1.f / D_) + EPS_);
        float gl[4] = {0.f, 0.f, 0.f, 0.f};
#pragma unroll
        for (int j = 0; j < 4; ++j) { v[j] = v[j] * rstd * gsc[j] + shv[j];
            u32x2 o; o.x = pk2(v[j][0], v[j][1]); o.y = pk2(v[j][2], v[j][3]);
            *(u32x2*)(H2 + (size_t)t * D_ + 4 * F.lane + 256 * j) = o;
#pragma unroll
            for (int g = 0; g < 4; ++g) { const f32x4 w = *(const LAS f32x4*)(wT + g * D_ + 4 * F.lane + 256 * j); gl[g] += (v[j][0] * w[0] + v[j][1] * w[1]) + (v[j][2] * w[2] + v[j][3] * w[3]); } }
        int gi = 0; float gm = -1e30f, gs = 0.f;
#pragma unroll
        for (int g = 0; g < 4; ++g) { gl[g] = wave_sum(gl[g]) + FIN(I_BRG)[g]; if (gl[g] > gm) { gm = gl[g]; gi = g; } }
#pragma unroll
        for (int g = 0; g < 4; ++g) gs += __expf(gl[g] - gm);
        gi = __builtin_amdgcn_readfirstlane(gi);
        const float gwt = 1.f / gs;
        float el[8] = {0.f, 0.f, 0.f, 0.f, 0.f, 0.f, 0.f, 0.f};
        const LAS float* we = wT + (4 + gi * 8) * D_;
#pragma unroll
        for (int j = 0; j < 4; ++j)
#pragma unroll
            for (int e = 0; e < 8; ++e) { const f32x4 w = *(const LAS f32x4*)(we + e * D_ + 4 * F.lane + 256 * j); el[e] += (v[j][0] * w[0] + v[j][1] * w[1]) + (v[j][2] * w[2] + v[j][3] * w[3]); }
        int i0 = 0, i1 = 0; float v0 = -1e30f, v1 = -1e30f;
#pragma unroll
        for (int e = 0; e < 8; ++e) { el[e] = wave_sum(el[e]) + FIN(I_BRE)[gi * 8 + e];
            if (el[e] > v0) { v1 = v0; i1 = i0; v0 = el[e]; i0 = e; } else if (el[e] > v1) { v1 = el[e]; i1 = e; } }
        const float e1 = __expf(v1 - v0), w0 = gwt / (1.f + e1), w1 = gwt * e1 / (1.f + e1);
        if (F.lane == 0) { const int ea = gi * 8 + i0, eb = gi * 8 + i1; toke[t * 2] = ea; toke[t * 2 + 1] = eb; tokw[t * 2] = w0; tokw[t * 2 + 1] = w1;
            __hip_atomic_fetch_add((LAS unsigned*)(LC + LC_CNT + ea), 1u, __ATOMIC_RELAXED, __HIP_MEMORY_SCOPE_WORKGROUP);
            __hip_atomic_fetch_add((LAS unsigned*)(LC + LC_CNT + eb), 1u, __ATOMIC_RELAXED, __HIP_MEMORY_SCOPE_WORKGROUP); }
    }
    __syncthreads();
    if (F.tid < 32) { const unsigned n = LC[LC_CNT + F.tid]; if (n) __hip_atomic_fetch_add((unsigned*)(F.ws + WS_CTL) + CW_CNT + F.tid, n, __ATOMIC_RELAXED, __HIP_MEMORY_SCOPE_AGENT); }
    __syncthreads();
}
__device__ __forceinline__ void moe_tile_starts(Frame& F) {
    volatile LAS unsigned* LC = (volatile LAS unsigned*)(F.lds + LDS_CTL);
    if (F.tid == 0) { const unsigned* cnt = (const unsigned*)(F.ws + WS_CTL) + CW_CNT; unsigned acc = 0;
        for (int e = 0; e < 32; ++e) { LC[LC_TST + e] = acc; acc += (__hip_atomic_load(cnt + e, __ATOMIC_RELAXED, __HIP_MEMORY_SCOPE_AGENT) + 255u) >> 8; }
        LC[LC_TST + 32] = acc; }
    __syncthreads();
}
__device__ __forceinline__ void p8_dispatch(Frame& F) {
    volatile LAS unsigned* LC = (volatile LAS unsigned*)(F.lds + LDS_CTL);
    if (F.tid < 32) LC[LC_CNT + F.tid] = 0u;
    moe_tile_starts(F);
    const int gw = F.vcu * NWAVES + F.wave, t0 = gw * 8;
    const int* toke = (const int*)(F.ws + WS_TOKE); int* tokpos = (int*)(F.ws + WS_TOKPOS);
    int e = 0; unsigned rk = 0;
    if (F.lane < 16) { e = toke[t0 * 2 + F.lane]; rk = __hip_atomic_fetch_add((LAS unsigned*)(LC + LC_CNT + e), 1u, __ATOMIC_RELAXED, __HIP_MEMORY_SCOPE_WORKGROUP); }
    __syncthreads();
    if (F.tid < 32) { const unsigned n = LC[LC_CNT + F.tid];
        LC[LC_BASE + F.tid] = n ? __hip_atomic_fetch_add((unsigned*)(F.ws + WS_CTL) + CW_CUR + F.tid, n, __ATOMIC_RELAXED, __HIP_MEMORY_SCOPE_AGENT) : 0u; }
    __syncthreads();
    int pos = 0;
    if (F.lane < 16) { pos = (int)(LC[LC_TST + e] * 256u + LC[LC_BASE + e] + rk); tokpos[t0 * 2 + F.lane] = pos; }
    const bf16_t* H2 = (const bf16_t*)(F.ws + WS_H); bf16_t* XS = (bf16_t*)(F.ws + WS_XS);
#pragma unroll 4
    for (int idx = 0; idx < 16; ++idx) { const int p = __shfl(pos, idx); const u32x4* src = (const u32x4*)(H2 + (size_t)(t0 + (idx >> 1)) * D_); u32x4* dst = (u32x4*)(XS + (size_t)p * D_);
        dst[F.lane] = src[F.lane]; dst[F.lane + 64] = src[F.lane + 64]; }
    __syncthreads();
}
__device__ __forceinline__ void p11_final(Frame& F) {
    const int gw = F.vcu * NWAVES + F.wave, t0 = gw * 8, b = t0 / S_;
    const float* g2 = (const float*)(F.ws + WS_MOD) + b * 6144 + 5120;
    const int* tokpos = (const int*)(F.ws + WS_TOKPOS); const float* tokw = (const float*)(F.ws + WS_TOKW); const bf16_t* Y = (const bf16_t*)(F.ws + WS_XS);
    f32x4 gv[4];
#pragma unroll
    for (int j = 0; j < 4; ++j) gv[j] = *(const f32x4*)(g2 + 4 * F.lane + 256 * j);
    for (int tt = 0; tt < 8; ++tt) { const int t = t0 + tt; const int p0 = tokpos[t * 2], p1 = tokpos[t * 2 + 1]; const float w0 = tokw[t * 2], w1 = tokw[t * 2 + 1];
#pragma unroll
        for (int j = 0; j < 4; ++j) { const int c = 4 * F.lane + 256 * j;
            const u32x2 a = *(const u32x2*)(Y + (size_t)p0 * D_ + c), bq = *(const u32x2*)(Y + (size_t)p1 * D_ + c);
            f32x4 y; y[0] = w0 * __uint_as_float(a.x << 16) + w1 * __uint_as_float(bq.x << 16); y[1] = w0 * __uint_as_float(a.x & 0xffff0000u) + w1 * __uint_as_float(bq.x & 0xffff0000u);
            y[2] = w0 * __uint_as_float(a.y << 16) + w1 * __uint_as_float(bq.y << 16); y[3] = w0 * __uint_as_float(a.y & 0xffff0000u) + w1 * __uint_as_float(bq.y & 0xffff0000u);
            float* op = F.out + (size_t)t * D_ + c; *(f32x4*)op = *(const f32x4*)op + gv[j] * y; }
    }
}
__global__ void __launch_bounds__(NTHR, 2) fwd(Args args) {
    extern __shared__ __attribute__((aligned(16))) unsigned char lds_raw[];
    Frame F;
    F.lds = (LAS unsigned char*)lds_raw; F.ldsg = lds_raw;
    F.tid = threadIdx.x; F.lane = F.tid & 63; F.wave = __builtin_amdgcn_readfirstlane(F.tid >> 6);
    F.G = gridDim.x; { const int bx = blockIdx.x; F.vcu = (F.G % 8 == 0) ? (bx % 8) * (F.G / 8) + bx / 8 : bx; }
    F.in = args.in; F.out = args.out; F.ws = args.ws;
    volatile LAS unsigned* LC = (volatile LAS unsigned*)(F.lds + LDS_CTL);
    for (int u = F.tid; u < 256; u += NTHR) LC[u] = 0u;
    __syncthreads();
    unsigned* ctl = (unsigned*)(F.ws + WS_CTL);
    const int lo = args.ph_lo, hi = args.ph_hi;
    const bool multi = (hi - lo) > 1;
    XcdBarrier bar; bar.bar = ctl + CW_BAR; bar.x = 0; bar.st = nullptr;
    if (multi) bar = xcd_barrier_post(ctl + CW_BAR, LC + LC_BAR);
#define IN(k) (lo <= (k) && (k) < hi)
#define SEAM(k) do { if (IN(k) && IN((k) + 1)) xcd_barrier(bar); } while (0)
    if (IN(0)) { p0_prologue(F); } SEAM(0);
    if (IN(1)) { p1_norm1(F); } SEAM(1);
    if (IN(2)) {
        pg8::Gemm g{(const char*)(F.ws + WS_H), (const char*)(F.ws + WS_WIN), D_ * 2, D_ * 2, D_};
        pg8::DenseOrder S; S.init(T_, NP, F.G, (int)blockIdx.x, g.lda, g.ldb);
        pg8::EpiProj E{(bf16_t*)(F.ws + WS_PROJ), FIN(I_QGAIN), FIN(I_KGAIN)};
        pg8::gemm_phase<pg8::EpiProj, pg8::DenseOrder, true>(F.lds, g, S, E);
    } SEAM(2);
    if (IN(3)) { p3a_dilated(F); } SEAM(3);
    if (IN(4)) { p3b_fox(F); } SEAM(4);
    if (IN(5)) {
        { pg8::Gemm g{(const char*)(F.ws + WS_YA), (const char*)(F.ws + WS_WA), 512 * 2, 512 * 2, 512};
          pg8::DenseOrder S; S.init(T_, D_, F.G, (int)blockIdx.x, g.lda, g.ldb);
          pg8::EpiBranch<0> E{(bf16_t*)(F.ws + WS_H), (const bf16_t*)(F.ws + WS_PROJ)};
          pg8::gemm_phase<pg8::EpiBranch<0>, pg8::DenseOrder, false>(F.lds, g, S, E); }
        { pg8::Gemm g{(const char*)(F.ws + WS_YD), (const char*)(F.ws + WS_WB), 256 * 2, 256 * 2, 256};
          pg8::DenseOrder S; S.init(T_, D_, F.G, (int)blockIdx.x, g.lda, g.ldb);
          pg8::EpiBranch<1> E{(bf16_t*)(F.ws + WS_H), (const bf16_t*)(F.ws + WS_PROJ)};
          pg8::gemm_phase<pg8::EpiBranch<1>, pg8::DenseOrder, false>(F.lds, g, S, E); }
    } SEAM(5);
    if (IN(6)) {
        pg8::Gemm g{(const char*)(F.ws + WS_H), (const char*)(F.ws + WS_WOUT), D_ * 2, D_ * 2, D_};
        pg8::DenseOrder S; S.init(T_, D_, F.G, (int)blockIdx.x, g.lda, g.ldb);
        pg8::EpiOut E{F.out, FIN(I_X), (const float*)(F.ws + WS_MOD)};
        pg8::gemm_phase<pg8::EpiOut, pg8::DenseOrder, false>(F.lds, g, S, E);
    } SEAM(6);
    if (IN(7)) { p7_norm2_router(F); } SEAM(7);
    if (IN(8)) { p8_dispatch(F); } SEAM(8);
    if (IN(9)) {
        moe_tile_starts(F);
        pg8::Gemm g{(const char*)(F.ws + WS_XS), (const char*)(F.ws + WS_W13), D_ * 2, D_ * 2, D_};
        pg8::MoeOrder S{(const volatile LAS int*)(LC + LC_TST), (int)LC[LC_TST + 32] * 4, F.G, F.vcu, 256u * g.lda, 256u * g.ldb, 1024u * g.ldb};
        pg8::EpiGateUp E{(bf16_t*)(F.ws + WS_HID)};
        pg8::gemm_phase<pg8::EpiGateUp, pg8::MoeOrder, true>(F.lds, g, S, E);
    } SEAM(9);
    if (IN(10)) {
        moe_tile_starts(F);
        pg8::Gemm g{(const char*)(F.ws + WS_HID), (const char*)(F.ws + WS_W2T), EH * 2, EH * 2, EH};
        pg8::MoeOrder S{(const volatile LAS int*)(LC + LC_TST), (int)LC[LC_TST + 32] * 4, F.G, F.vcu, 256u * g.lda, 256u * g.ldb, 1024u * g.ldb};
        pg8::EpiBf16 E{(bf16_t*)(F.ws + WS_XS), D_};
        pg8::gemm_phase<pg8::EpiBf16, pg8::MoeOrder, true>(F.lds, g, S, E);
    } SEAM(10);
    if (IN(11)) { p11_final(F); }
#undef IN
#undef SEAM
}
}
#define MK_LAUNCH_PROGRAM mk_launch(a, 0, 12, stream);
static int g_grid = 0;
static void mk_launch(const Args& a0, int lo, int hi, hipStream_t st) {
    Args a = a0; a.ph_lo = lo; a.ph_hi = hi;
    hipLaunchKernelGGL(mk::fwd, dim3(g_grid), dim3(mk::NTHR), mk::LDS_BYTES, st, a);
}
extern "C" void kernel_launch(void* const* d_in, const int* in_sizes, int n_in, void* d_out, int out_size, void* d_ws, size_t ws_size, hipStream_t stream) {
    if (n_in != N_INPUTS || out_size != T_ * D_ || ws_size < WS_END) { fprintf(stderr, "kernel_launch: unexpected shapes n_in %d out %d ws %zu\n", n_in, out_size, ws_size); return; }
    if (g_grid == 0) {
        int dev = 0, cus = 0, per_cu = 0;
        if (hipGetDevice(&dev) != hipSuccess || hipDeviceGetAttribute(&cus, hipDeviceAttributeMultiprocessorCount, dev) != hipSuccess) { g_grid = -1; return; }
        if (hipFuncSetAttribute((const void*)mk::fwd, hipFuncAttributeMaxDynamicSharedMemorySize, mk::LDS_BYTES) != hipSuccess) { fprintf(stderr, "hipFuncSetAttribute failed\n"); g_grid = -1; return; }
        if (hipOccupancyMaxActiveBlocksPerMultiprocessor(&per_cu, (const void*)mk::fwd, mk::NTHR, mk::LDS_BYTES) != hipSuccess || per_cu < 1) { fprintf(stderr, "occupancy query: %d\n", per_cu); }
        (void)hipGetLastError();
        g_grid = cus;
    }
    if (g_grid < 0) return;
    (void)hipMemsetAsync((char*)d_ws + WS_CTL, 0, CTL_BYTES, stream);
    Args a{};
    for (int i = 0; i < N_INPUTS; ++i) a.in[i] = (const float*)d_in[i];
    a.out = (float*)d_out; a.ws = (unsigned char*)d_ws;
    MK_LAUNCH_PROGRAM
}
```

```cpp
#include <hip/hip_runtime.h>
#include <cstdio>
#include <cstdint>

#define LAS __attribute__((address_space(3)))
#define GAS __attribute__((address_space(1)))
typedef unsigned short bf16_t;
typedef short bf16x8 __attribute__((ext_vector_type(8)));
typedef short s16x4 __attribute__((ext_vector_type(4)));
typedef float f32x2 __attribute__((ext_vector_type(2)));
typedef float f32x4 __attribute__((ext_vector_type(4)));
typedef float f32x16 __attribute__((ext_vector_type(16)));
typedef unsigned u32x2 __attribute__((ext_vector_type(2)));
typedef unsigned u32x4 __attribute__((ext_vector_type(4)));
typedef __bf16 bf16x2_t __attribute__((ext_vector_type(2)));

constexpr int T_ = 16384, D_ = 1024, B_ = 8, S_ = 2048;
constexpr int NIN = 5896, NP = 5888;
constexpr int PC_FQ = 0, PC_FK = 512, PC_FV = 1024, PC_DQ = 1536, PC_DK = 2304, PC_DV = 3072, PC_GA = 3840, PC_GB = 4864;
constexpr int SRC_FORGET = 1536;
constexpr float EPS_ = 1e-6f, LOG2E = 1.4426950408889634f, C2 = 0.125f * 1.4426950408889634f;
constexpr int NEXP = 32, EH = 512;
constexpr int RMAX = 40960;

constexpr size_t MiB = 1u << 20;
constexpr size_t WS_CTL = 0, CTL_BYTES = 1 * MiB;
constexpr int CW_CNT = 256, CW_CUR = 512, CW_QUEUE = 768, CW_BAR = 4096;
constexpr size_t WS_MOD = 64 * 1024;
constexpr size_t WS_LOGF = 1 * MiB;
constexpr size_t WS_LSE = 1 * MiB + 512 * 1024;
constexpr size_t WS_TOKE = 2 * MiB + 512 * 1024;
constexpr size_t WS_TOKW = 2 * MiB + 768 * 1024;
constexpr size_t WS_TOKPOS = 3 * MiB;
constexpr size_t WS_WA = 8 * MiB, WS_WB = 9 * MiB, WS_WOUT = 10 * MiB, WS_WIN = 12 * MiB;
constexpr size_t WS_H = 24 * MiB;
constexpr size_t WS_PROJ = 56 * MiB;
constexpr size_t WS_YA = 240 * MiB;
constexpr size_t WS_OG = 256 * MiB;
constexpr size_t WS_YD = 280 * MiB;
constexpr size_t WS_END = 288 * MiB;
constexpr size_t WS_W13 = 56 * MiB, WS_W2T = 120 * MiB, WS_XS = 152 * MiB, WS_HID = 232 * MiB;

__device__ __forceinline__ float bf2f(bf16_t b) { return __uint_as_float(((unsigned)b) << 16); }
__device__ __forceinline__ unsigned pk2(float lo, float hi) { f32x2 v = {lo, hi}; bf16x2_t b = __builtin_convertvector(v, bf16x2_t); return __builtin_bit_cast(unsigned, b); }
__device__ __forceinline__ bf16_t f2bf(float f) { return (bf16_t)(pk2(f, 0.f) & 0xffffu); }
__device__ __forceinline__ float silu_f(float x) { return x / (1.f + __expf(-x)); }
__device__ __forceinline__ float sigmoid_f(float x) { return 1.f / (1.f + __expf(-x)); }
__device__ __forceinline__ float wave_sum(float v) {
#pragma unroll
    for (int o = 1; o < 64; o <<= 1) v += __shfl_xor(v, o);
    return v;
}

__device__ __forceinline__ float rdlane(float v, int l) { return __int_as_float(__builtin_amdgcn_readlane(__float_as_int(v), l)); }
__device__ __forceinline__ void wave_reduce8(float (&v)[8], int lane) {
    const bool h32 = lane & 32, h16 = lane & 16, h8 = lane & 8;
    float a[4], b[2], c;
#pragma unroll
    for (int i = 0; i < 4; ++i) { const float keep = h32 ? v[4 + i] : v[i], send = h32 ? v[i] : v[4 + i]; a[i] = keep + __shfl_xor(send, 32); }
#pragma unroll
    for (int i = 0; i < 2; ++i) { const float keep = h16 ? a[2 + i] : a[i], send = h16 ? a[i] : a[2 + i]; b[i] = keep + __shfl_xor(send, 16); }
    { const float keep = h8 ? b[1] : b[0], send = h8 ? b[0] : b[1]; c = keep + __shfl_xor(send, 8); }
    c += __shfl_xor(c, 4); c += __shfl_xor(c, 2); c += __shfl_xor(c, 1);
#pragma unroll
    for (int j = 0; j < 8; ++j) v[j] = rdlane(c, ((j & 4) ? 32 : 0) + ((j & 2) ? 16 : 0) + ((j & 1) ? 8 : 0));
}
__device__ __forceinline__ void wave_reduce4(float (&v)[4], int lane) {
    const bool h32 = lane & 32, h16 = lane & 16;
    float a[2], c;
#pragma unroll
    for (int i = 0; i < 2; ++i) { const float keep = h32 ? v[2 + i] : v[i], send = h32 ? v[i] : v[2 + i]; a[i] = keep + __shfl_xor(send, 32); }
    { const float keep = h16 ? a[1] : a[0], send = h16 ? a[0] : a[1]; c = keep + __shfl_xor(send, 16); }
    c += __shfl_xor(c, 8); c += __shfl_xor(c, 4); c += __shfl_xor(c, 2); c += __shfl_xor(c, 1);
#pragma unroll
    for (int j = 0; j < 4; ++j) v[j] = rdlane(c, ((j & 2) ? 32 : 0) + ((j & 1) ? 16 : 0));
}

__constant__ unsigned char T5BUCKET[3][132] = {
{0,1,2,3,4,5,6,7,8,9,10,11,12,13,14,15,16,16,16,16,16,16,17,17,17,17,17,17,17,17,18,18,18,18,18,18,18,18,18,18,19,19,19,19,19,19,19,19,19,19,19,19,19,19,20,20,20,20,20,20,20,20,20,20,20,20,20,20,20,20,20,20,20,21,21,21,21,21,21,21,21,21,21,21,21,21,21,21,21,21,21,21,21,21,21,21,21,21,21,22,22,22,22,22,22,22,22,22,22,22,22,22,22,22,22,22,22,22,22,22,22,22,22,22,22,22,22,22,22,0,0,0},
{0,4,8,12,16,16,17,17,18,18,19,19,19,19,20,20,20,20,20,21,21,21,21,21,21,22,22,22,22,22,22,22,22,22,23,23,23,23,23,23,23,23,23,23,23,23,24,24,24,24,24,24,24,24,24,24,24,24,24,24,24,24,25,25,25,25,25,25,25,25,25,25,25,25,25,25,25,25,25,25,25,25,25,26,26,26,26,26,26,26,26,26,26,26,26,26,26,26,26,26,26,26,26,26,26,26,26,26,26,26,26,26,26,27,27,27,27,27,27,27,27,27,27,27,27,27,27,27,27,0,0,0},
{0,16,18,19,20,21,21,22,22,23,23,23,24,24,24,24,25,25,25,25,25,26,26,26,26,26,26,26,26,27,27,27,27,27,27,27,27,27,27,28,28,28,28,28,28,28,28,28,28,28,28,28,29,29,29,29,29,29,29,29,29,29,29,29,29,29,29,29,29,29,30,30,30,30,30,30,30,30,30,30,30,30,30,30,30,30,30,30,30,30,30,30,30,30,30,31,31,31,31,31,31,31,31,31,31,31,31,31,31,31,31,31,31,31,31,31,31,31,31,31,31,31,31,31,31,31,31,31,31,0,0,0}};

enum { I_X = 0, I_C, I_TABLE, I_WADA, I_BADA, I_N1G, I_WIN, I_BFORGET, I_QGAIN, I_KGAIN, I_WBA, I_WBB, I_WOUT, I_N2G, I_WRG, I_BRG, I_WRE, I_BRE, I_W1, I_W3, I_W2, N_INPUTS };
struct Args { const float* in[N_INPUTS]; float* out; unsigned char* ws; int ph_lo, ph_hi, li, pad; };
static_assert(sizeof(Args) == (N_INPUTS + 2) * 8 + 16, "Args has no padding");
namespace mk {
constexpr int NWAVES = 8, NTHR = 512;
constexpr int LDS_SCRATCH = 148480;
constexpr int LDS_CTL = LDS_SCRATCH;
constexpr int LDS_BYTES = LDS_SCRATCH + 1024;
constexpr int LC_BAR = 8, LC_CNT = 16, LC_BASE = 48, LC_TST = 80, LC_BC = 120;

#define LDS_WAIT() asm volatile("s_waitcnt lgkmcnt(0)" ::: "memory")
#define VM_WAIT() asm volatile("s_waitcnt vmcnt(0)" ::: "memory")

#define XB_TMO      128
#define XB_XCNT(j)  (256  + 64 * (j))
#define XB_XSUB(j)  (1280 + 64 * (j))
#define XB_XGEN(j)  (2304 + 64 * (j))
#define XB_TOP      3328
#define XB_TOPGEN   3392
#define XCD_BAR_WORDS 3456
#define XB_SPIN_CAP (1u << 18)

__device__ __forceinline__ unsigned xb_ld(unsigned* p)              { return __hip_atomic_load(p, __ATOMIC_RELAXED, __HIP_MEMORY_SCOPE_AGENT); }
__device__ __forceinline__ unsigned xb_add(unsigned* p, unsigned v) { return __hip_atomic_fetch_add(p, v, __ATOMIC_RELAXED, __HIP_MEMORY_SCOPE_AGENT); }
__device__ __forceinline__ unsigned xb_xcc_id() { return (unsigned)__builtin_amdgcn_s_getreg((3 << 11) | 20) & 0xFu; }
#define XB_SPIN(cond, bar) do { unsigned _sp = 0; while (cond) { __builtin_amdgcn_s_sleep(1); \
    if ((++_sp & 255u) == 0u) { if (xb_ld(&(bar)[XB_TMO])) break; if (_sp > XB_SPIN_CAP) { atomicAdd(&(bar)[XB_TMO], 1u); break; } } } } while (0)

struct XcdBarrier {
    unsigned* bar; unsigned x;
    volatile LAS unsigned* st;
};

__device__ __forceinline__ XcdBarrier xcd_barrier_post(unsigned* bar, volatile LAS unsigned* st) {
    XcdBarrier b; b.bar = bar; b.x = xb_xcc_id(); b.st = st;
    if (threadIdx.x == 0) (void)xb_add(&bar[XB_XCNT(b.x)], 1u);
    return b;
}
__device__ __forceinline__ void xcd_barrier_complete(unsigned* bar, unsigned x, unsigned& nloc, unsigned& nx) {
    const unsigned G = gridDim.x * gridDim.y * gridDim.z;
    unsigned sum, cnt, mine, sp = 0u;
    for (;;) {
        sum = 0u; cnt = 0u; mine = 0u;
#pragma unroll
        for (unsigned j = 0; j < 16; ++j) { const unsigned c = xb_ld(&bar[XB_XCNT(j)]); sum += c; cnt += (c > 0u) ? 1u : 0u; mine = (j == x) ? c : mine; }
        if (sum == G) break;
        __builtin_amdgcn_s_sleep(1);
        if ((++sp & 255u) == 0u) { if (xb_ld(&bar[XB_TMO])) break; if (sp > XB_SPIN_CAP) { atomicAdd(&bar[XB_TMO], 1u); break; } }
    }
    nloc = mine > 0u ? mine : 1u; nx = cnt > 0u ? cnt : 1u;
}

__device__ __forceinline__ void xcd_barrier(const XcdBarrier& b) {
    asm volatile("s_waitcnt vmcnt(0)" ::: "memory");
    __syncthreads();
    if (threadIdx.x == 0) {
        unsigned* bar = b.bar;
        __builtin_amdgcn_s_waitcnt(0);
        unsigned nloc = b.st[0], nx = b.st[1];
        if (nloc == 0u) { xcd_barrier_complete(bar, b.x, nloc, nx); b.st[0] = nloc; b.st[1] = nx; }
        const unsigned old = xb_add(&bar[XB_XSUB(b.x)], 1u);
        const unsigned gen = old / nloc;
        if (old + 1u == (gen + 1u) * nloc) {
            __builtin_amdgcn_fence(__ATOMIC_RELEASE, "agent");
            asm volatile("s_waitcnt vmcnt(0)" ::: "memory");
            const unsigned og = xb_add(&bar[XB_TOP], 1u);
            const unsigned tg = og / nx;
            if (og + 1u == (tg + 1u) * nx) xb_add(&bar[XB_TOPGEN], 1u);
            else XB_SPIN(xb_ld(&bar[XB_TOPGEN]) == tg, bar);
            __builtin_amdgcn_fence(__ATOMIC_ACQUIRE, "agent");
            xb_add(&bar[XB_XGEN(b.x)], 1u);
            asm volatile("s_waitcnt vmcnt(0)" ::: "memory");
        } else {
            XB_SPIN(xb_ld(&bar[XB_XGEN(b.x)]) == gen, bar);
            __builtin_amdgcn_fence(__ATOMIC_ACQUIRE, "agent");
            asm volatile("s_waitcnt vmcnt(0)" ::: "memory");
        }
    }
    __syncthreads();
}

namespace pg8 {
constexpr int BM = 256, BK = 64, HALF = 128, HTB = HALF * BK * 2, STAGE_BYTES = 8 * HTB, NXCD = 8, WGM = 8;
__host__ __device__ __forceinline__ int lds_byte(int r, int c) { const int st = (r >> 4) * 2 + (c >> 5), rr = r & 15, cc = c & 31, ob = rr * 64 + cc * 2; return st * 1024 + (ob ^ (((ob >> 9) & 1) << 5)); }
__host__ __device__ __forceinline__ void stage_rc(int b, int& R, int& C) { const int st = b / 1024, sb = b % 1024, swz = sb ^ (((sb >> 9) & 1) << 5); R = (st >> 1) * 16 + swz / 64; C = (st & 1) * 32 + (swz % 64) / 2; }
__host__ __device__ __forceinline__ int perm32(int rho) { const int n = rho >> 4, i = rho & 15; return 8 * (i >> 2) + 4 * n + (i & 3); }
struct Unit { int pm, pn, e; unsigned aoff, boff; };
struct Gemm { const char* A; const char* Bt; unsigned lda, ldb; int K; };

struct DenseOrder {
    int nM, nN, nwg, G, c; unsigned a256, b256;
    __device__ void init(int M, int N, int G_, int c_, unsigned lda, unsigned ldb) { nM = M / BM; nN = N / BM; nwg = nM * nN; G = G_; c = c_; a256 = 256u * lda; b256 = 256u * ldb; }
    __device__ bool next(int i, Unit& u) const {
        const long L = (long)i * G + c; if (L >= nwg) return false;
        int wgid = (int)L; { const int q = nwg / NXCD, r = nwg % NXCD, xcd = wgid % NXCD, off = wgid / NXCD; wgid = (xcd < r ? xcd * (q + 1) : r * (q + 1) + (xcd - r) * q) + off; }
        const int nig = WGM * nN, gid = wgid / nig, fm = gid * WGM, gsz = (nM - fm) < WGM ? (nM - fm) : WGM;
        u.pm = fm + ((wgid % nig) % gsz); u.pn = (wgid % nig) / gsz; u.e = 0; u.aoff = (unsigned)u.pm * a256; u.boff = (unsigned)u.pn * b256; return true;
    }
};
struct MoeOrder {
    const volatile LAS int* tstart; int nunits, G, c; unsigned a256, b256, bexp;
    __device__ bool next(int i, Unit& u) const {
        const int L = i * G + c; if (L >= nunits) return false;
        const int rt = L >> 2, j = L & 3; int e = 0;
        for (int k = 1; k < 32; ++k) e += (tstart[k] <= rt) ? 1 : 0;
        e = __builtin_amdgcn_readfirstlane(e);
        u.pm = rt; u.pn = j; u.e = e; u.aoff = (unsigned)rt * a256; u.boff = (unsigned)e * bexp + (unsigned)j * b256; return true;
    }
};

template <class Epi, class Sched, bool ALIGN_EPI>
__device__ __forceinline__ void gemm_phase(LAS unsigned char* lds, const Gemm g, const Sched& S, const Epi& E) {
    const int tid = threadIdx.x, wid = __builtin_amdgcn_readfirstlane(tid >> 6), lane = tid & 63, wr = wid >> 2, wc = wid & 3, fr = lane & 15, fq = lane >> 4;
    const int K = g.K, nt = K / BK;
    unsigned voffA[2], voffB[2];
#pragma unroll
    for (int i = 0; i < 2; ++i) { int R, C; stage_rc(tid * 16 + i * 8192, R, C); const int Rb = Epi::PERM ? ((R & ~31) + perm32(R & 31)) : R;
        voffA[i] = (unsigned)R * g.lda + (unsigned)C * 2u; voffB[i] = (unsigned)Rb * g.ldb + (unsigned)C * 2u; }
    const size_t kstep = (size_t)(BK * 2);
    const size_t hstepA = (size_t)HALF * g.lda, hstepB = (size_t)HALF * g.ldb;
    const unsigned ldsw = (unsigned)wid * 1024u;
    const int aoff = lds_byte(wr * 64 + fr, fq * 8), boff = lds_byte(wc * 32 + fr, fq * 8);
#define PG8_SA(b, h) (((b) * 2 + (h)) * HTB)
#define PG8_SB(b, h) ((4 + (b) * 2 + (h)) * HTB)
#define PG8_STAGE(bufoff, gbase, voff) do { _Pragma("unroll") for (int _i = 0; _i < 2; ++_i) \
        __builtin_amdgcn_global_load_lds((const unsigned*)((const char*)(gbase) + (voff)[_i]), (LAS unsigned*)(lds + (bufoff) + ldsw + _i * 8192), 16, 0, 0); } while (0)
#define PG8_LDA(dst, b, h) do { _Pragma("unroll") for (int m = 0; m < 4; ++m) _Pragma("unroll") for (int k = 0; k < 2; ++k) dst[m][k] = *(const LAS bf16x8*)(lds + PG8_SA(b, h) + aoff + m * 2048 + k * 1024); } while (0)
#define PG8_LDB(dst, b, h) do { _Pragma("unroll") for (int n = 0; n < 2; ++n) _Pragma("unroll") for (int k = 0; k < 2; ++k) dst[n][k] = *(const LAS bf16x8*)(lds + PG8_SB(b, h) + boff + n * 2048 + k * 1024); } while (0)
#define PG8_MMA(ai, bj, At, Bt) do { __builtin_amdgcn_s_setprio(1); _Pragma("unroll") for (int m = 0; m < 4; ++m) _Pragma("unroll") for (int n = 0; n < 2; ++n) _Pragma("unroll") for (int k = 0; k < 2; ++k) \
        acc[ai][bj][m][n] = __builtin_amdgcn_mfma_f32_16x16x32_bf16(Bt[n][k], At[m][k], acc[ai][bj][m][n], 0, 0, 0); __builtin_amdgcn_s_setprio(0); } while (0)
#define PG8_WAIT_V(n) asm volatile("s_waitcnt vmcnt(" #n ")" ::: "memory")
#define PG8_WAIT_L(n) asm volatile("s_waitcnt lgkmcnt(" #n ")" ::: "memory")
#define PG8_BAR __builtin_amdgcn_s_barrier()
#define PG8_SCHED __builtin_amdgcn_sched_barrier(0)
    Unit cur, nxt; int ui = 0;
    if (!S.next(0, cur)) return;
    f32x4 acc[2][2][4][2];
#pragma unroll
    for (int a = 0; a < 2; ++a)
#pragma unroll
        for (int b = 0; b < 2; ++b)
#pragma unroll
            for (int m = 0; m < 4; ++m)
#pragma unroll
                for (int n = 0; n < 2; ++n) acc[a][b][m][n] = (f32x4){0.f, 0.f, 0.f, 0.f};
    bf16x8 At[4][2], B0[2][2], B1[2][2];
    const char* cA = g.A + cur.aoff; const char* cB = g.Bt + cur.boff;
    PG8_STAGE(PG8_SB(0, 0), cB, voffB); PG8_STAGE(PG8_SB(0, 1), cB + hstepB, voffB); PG8_STAGE(PG8_SA(0, 0), cA, voffA); PG8_STAGE(PG8_SA(0, 1), cA + hstepA, voffA);
    if (wr == 1) PG8_BAR;
    PG8_WAIT_V(2); PG8_BAR;
    PG8_STAGE(PG8_SB(1, 0), cB + kstep, voffB); PG8_STAGE(PG8_SA(1, 0), cA + kstep, voffA); PG8_STAGE(PG8_SB(1, 1), cB + hstepB + kstep, voffB);
    PG8_WAIT_V(6); PG8_BAR;
    for (;;) {
        const bool has_next = S.next(ui + 1, nxt);
        const char* nA = has_next ? g.A + nxt.aoff : cA; const char* nB = has_next ? g.Bt + nxt.boff : cB;
        for (int t = 0; t < nt; t += 2) {
            const bool last = (t == nt - 2);
            const char* a1 = cA + (size_t)(t + 1) * kstep;
            const char* a2 = last ? nA : cA + (size_t)(t + 2) * kstep; const char* b2 = last ? nB : cB + (size_t)(t + 2) * kstep;
            const char* a3 = a2 + kstep; const char* b3 = b2 + kstep;
            PG8_LDB(B0, 0, 0); PG8_LDB(B1, 0, 1); PG8_SCHED; PG8_LDA(At, 0, 0); PG8_STAGE(PG8_SA(1, 1), a1 + hstepA, voffA);
            PG8_WAIT_V(8); PG8_WAIT_L(0); PG8_BAR; PG8_MMA(0, 0, At, B0); PG8_MMA(0, 1, At, B1); PG8_BAR; PG8_SCHED;
            PG8_LDA(At, 0, 1); PG8_STAGE(PG8_SB(0, 0), b2, voffB); PG8_STAGE(PG8_SB(0, 1), b2 + hstepB, voffB); PG8_STAGE(PG8_SA(0, 0), a2, voffA);
            PG8_WAIT_V(8); PG8_WAIT_L(0); PG8_BAR; PG8_MMA(1, 0, At, B0); PG8_MMA(1, 1, At, B1); PG8_BAR; PG8_SCHED;
            PG8_LDB(B0, 1, 0); PG8_LDB(B1, 1, 1); PG8_SCHED; PG8_LDA(At, 1, 0); PG8_STAGE(PG8_SA(0, 1), a2 + hstepA, voffA);
            PG8_WAIT_V(8); PG8_WAIT_L(0); PG8_BAR; PG8_MMA(0, 0, At, B0); PG8_MMA(0, 1, At, B1); PG8_BAR; PG8_SCHED;
            PG8_LDA(At, 1, 1); PG8_STAGE(PG8_SB(1, 0), b3, voffB); PG8_STAGE(PG8_SB(1, 1), b3 + hstepB, voffB); PG8_STAGE(PG8_SA(1, 0), a3, voffA);
            PG8_WAIT_V(8); PG8_WAIT_L(0); PG8_BAR; PG8_MMA(1, 0, At, B0); PG8_MMA(1, 1, At, B1); PG8_BAR; PG8_SCHED;
        }
        if constexpr (ALIGN_EPI) { if (wr == 0) PG8_BAR; }
        E(acc, cur, wr, wc, fr, fq);
        if (!has_next) break;
#pragma unroll
        for (int a = 0; a < 2; ++a)
#pragma unroll
            for (int b = 0; b < 2; ++b)
#pragma unroll
                for (int m = 0; m < 4; ++m)
#pragma unroll
                    for (int n = 0; n < 2; ++n) acc[a][b][m][n] = (f32x4){0.f, 0.f, 0.f, 0.f};
        cur = nxt; cA = nA; cB = nB; ++ui;
        if constexpr (ALIGN_EPI) { if (wr == 1) PG8_BAR; }
    }
    PG8_WAIT_V(0);
    if constexpr (!ALIGN_EPI) { if (wr == 0) PG8_BAR; }
    PG8_BAR;
#undef PG8_SA
#undef PG8_SB
#undef PG8_STAGE
#undef PG8_LDA
#undef PG8_LDB
#undef PG8_MMA
#undef PG8_WAIT_V
#undef PG8_WAIT_L
#undef PG8_BAR
#undef PG8_SCHED
}

struct EpiProj {
    static constexpr bool PERM = true;
    bf16_t* P; const float* qg; const float* kg;
    __device__ __forceinline__ void operator()(const f32x4 (&acc)[2][2][4][2], const Unit& u, int wr, int wc, int fr, int fq) const {
        const int ch = u.pn * 4 + wc, c0 = ch * 64;
        int kind = 0; const float* g = qg; float sc = 1.f;
        if (c0 < PC_FK) { kind = 1; g = qg + ch * 64; sc = C2; }
        else if (c0 < PC_FV) { kind = 1; g = kg + (ch - 8) * 64; }
        else if (c0 < PC_DQ) kind = 0;
        else if (c0 < PC_DK) { kind = 1; g = qg + (8 + ch - 24) * 64; sc = C2; }
        else if (c0 < PC_DV) { kind = 1; g = kg + (8 + ch - 36) * 64; }
        else if (c0 < PC_GA) kind = 0;
        else kind = 2;
        f32x4 gv[2][2];
#pragma unroll
        for (int bj = 0; bj < 2; ++bj)
#pragma unroll
            for (int n = 0; n < 2; ++n) gv[bj][n] = (kind == 1) ? *(const f32x4*)(g + 32 * bj + 8 * fq + 4 * n) : (f32x4){1.f, 1.f, 1.f, 1.f};
        const int row0 = u.pm * BM + wr * 64 + fr;
#pragma unroll
        for (int ai = 0; ai < 2; ++ai)
#pragma unroll
            for (int m = 0; m < 4; ++m) {
                f32x4 v[2][2];
#pragma unroll
                for (int bj = 0; bj < 2; ++bj)
#pragma unroll
                    for (int n = 0; n < 2; ++n) v[bj][n] = acc[ai][bj][m][n];
                if (kind == 1) {
                    float ss = 0.f;
#pragma unroll
                    for (int bj = 0; bj < 2; ++bj)
#pragma unroll
                        for (int n = 0; n < 2; ++n) ss += (v[bj][n][0] * v[bj][n][0] + v[bj][n][1] * v[bj][n][1]) + (v[bj][n][2] * v[bj][n][2] + v[bj][n][3] * v[bj][n][3]);
                    ss += __shfl_xor(ss, 16); ss += __shfl_xor(ss, 32);
                    const float r = rsqrtf(ss * (1.f / 64.f) + EPS_) * sc;
#pragma unroll
                    for (int bj = 0; bj < 2; ++bj)
#pragma unroll
                        for (int n = 0; n < 2; ++n) v[bj][n] = v[bj][n] * r * gv[bj][n];
                } else if (kind == 2) {
#pragma unroll
                    for (int bj = 0; bj < 2; ++bj)
#pragma unroll
                        for (int n = 0; n < 2; ++n)
#pragma unroll
                            for (int j = 0; j < 4; ++j) v[bj][n][j] = __builtin_amdgcn_rcpf(1.f + __builtin_amdgcn_exp2f(-LOG2E * v[bj][n][j]));
                }
                bf16_t* rowp = P + (size_t)(row0 + ai * HALF + m * 16) * NP + c0 + 8 * fq;
#pragma unroll
                for (int bj = 0; bj < 2; ++bj) { u32x4 w; w.x = pk2(v[bj][0][0], v[bj][0][1]); w.y = pk2(v[bj][0][2], v[bj][0][3]); w.z = pk2(v[bj][1][0], v[bj][1][1]); w.w = pk2(v[bj][1][2], v[bj][1][3]);
                    *(u32x4*)(rowp + 32 * bj) = w; }
            }
    }
};
__device__ __forceinline__ void unpack8(const u32x4 w, float (&f)[8]) {
    f[0] = __uint_as_float(w.x << 16); f[1] = __uint_as_float(w.x & 0xffff0000u); f[2] = __uint_as_float(w.y << 16); f[3] = __uint_as_float(w.y & 0xffff0000u);
    f[4] = __uint_as_float(w.z << 16); f[5] = __uint_as_float(w.z & 0xffff0000u); f[6] = __uint_as_float(w.w << 16); f[7] = __uint_as_float(w.w & 0xffff0000u);
}
template <int MODE> struct EpiBranch {
    static constexpr bool PERM = true;
    bf16_t* MG; const bf16_t* P;
    __device__ __forceinline__ void operator()(const f32x4 (&acc)[2][2][4][2], const Unit& u, int wr, int wc, int fr, int fq) const {
        const int row0 = u.pm * BM + wr * 64 + fr, col0 = u.pn * BM + wc * 32 + 8 * fq;
#pragma unroll
        for (int ai = 0; ai < 2; ++ai)
#pragma unroll
            for (int m = 0; m < 4; ++m) { const size_t row = (size_t)(row0 + ai * HALF + m * 16);
                asm volatile("" ::: "memory");
#pragma unroll
                for (int bj = 0; bj < 2; ++bj) { const int col = col0 + bj * HALF;
                    float gt[8]; unpack8(*(const u32x4*)(P + row * NP + (MODE == 0 ? PC_GA : PC_GB) + col), gt);
                    f32x4 v0 = acc[ai][bj][m][0], v1 = acc[ai][bj][m][1];
                    float o[8] = {v0[0] * gt[0], v0[1] * gt[1], v0[2] * gt[2], v0[3] * gt[3], v1[0] * gt[4], v1[1] * gt[5], v1[2] * gt[6], v1[3] * gt[7]};
                    if (MODE == 1) { float pv[8]; unpack8(*(const u32x4*)(MG + row * D_ + col), pv);
#pragma unroll
                        for (int j = 0; j < 8; ++j) o[j] += pv[j]; }
                    u32x4 w; w.x = pk2(o[0], o[1]); w.y = pk2(o[2], o[3]); w.z = pk2(o[4], o[5]); w.w = pk2(o[6], o[7]);
                    *(u32x4*)(MG + row * D_ + col) = w; } }
    }
};
struct EpiOut {
    static constexpr bool PERM = false;
    float* x1; const float* x; const float* mod;
    __device__ __forceinline__ void operator()(const f32x4 (&acc)[2][2][4][2], const Unit& u, int wr, int wc, int fr, int fq) const {
        const int row0 = u.pm * BM + wr * 64 + fr, col0 = u.pn * BM + wc * 32 + 4 * fq;
        const float* g1 = mod + (u.pm >> 3) * 6144 + 2048;
        f32x4 gv[2][2];
#pragma unroll
        for (int bj = 0; bj < 2; ++bj)
#pragma unroll
            for (int n = 0; n < 2; ++n) gv[bj][n] = *(const f32x4*)(g1 + col0 + bj * HALF + n * 16);
#pragma unroll
        for (int ai = 0; ai < 2; ++ai)
#pragma unroll
            for (int m = 0; m < 4; ++m) { const size_t ro = (size_t)(row0 + ai * HALF + m * 16) * D_ + col0;
#pragma unroll
                for (int bj = 0; bj < 2; ++bj)
#pragma unroll
                    for (int n = 0; n < 2; ++n) { const f32x4 xv = *(const f32x4*)(x + ro + bj * HALF + n * 16);
                        *(f32x4*)(x1 + ro + bj * HALF + n * 16) = xv + gv[bj][n] * acc[ai][bj][m][n]; } }
    }
};
struct EpiGateUp {
    static constexpr bool PERM = true;
    bf16_t* HID;
    __device__ __forceinline__ void operator()(const f32x4 (&acc)[2][2][4][2], const Unit& u, int wr, int wc, int fr, int fq) const {
        const int row0 = u.pm * BM + wr * 64 + fr, col0 = u.pn * 128 + wc * 32 + 8 * fq;
#pragma unroll
        for (int ai = 0; ai < 2; ++ai)
#pragma unroll
            for (int m = 0; m < 4; ++m) { float o[8];
#pragma unroll
                for (int n = 0; n < 2; ++n)
#pragma unroll
                    for (int j = 0; j < 4; ++j) { const float a = acc[ai][0][m][n][j], up = acc[ai][1][m][n][j];
                        o[n * 4 + j] = a * __builtin_amdgcn_rcpf(1.f + __builtin_amdgcn_exp2f(-LOG2E * a)) * up; }
                u32x4 w; w.x = pk2(o[0], o[1]); w.y = pk2(o[2], o[3]); w.z = pk2(o[4], o[5]); w.w = pk2(o[6], o[7]);
                *(u32x4*)(HID + (size_t)(row0 + ai * HALF + m * 16) * EH + col0) = w; }
    }
};
struct EpiBf16 {
    static constexpr bool PERM = true;
    bf16_t* O; int ldc;
    __device__ __forceinline__ void operator()(const f32x4 (&acc)[2][2][4][2], const Unit& u, int wr, int wc, int fr, int fq) const {
        const int row0 = u.pm * BM + wr * 64 + fr, col0 = u.pn * BM + wc * 32 + 8 * fq;
#pragma unroll
        for (int ai = 0; ai < 2; ++ai)
#pragma unroll
            for (int m = 0; m < 4; ++m) { bf16_t* rowp = O + (size_t)(row0 + ai * HALF + m * 16) * ldc + col0;
#pragma unroll
                for (int bj = 0; bj < 2; ++bj) { const f32x4 v0 = acc[ai][bj][m][0], v1 = acc[ai][bj][m][1];
                    u32x4 w; w.x = pk2(v0[0], v0[1]); w.y = pk2(v0[2], v0[3]); w.z = pk2(v1[0], v1[1]); w.w = pk2(v1[2], v1[3]);
                    *(u32x4*)(rowp + bj * HALF) = w; } }
    }
};
}
struct Frame {
    LAS unsigned char* lds; unsigned char* ldsg;
    int tid, lane, wave, vcu, G;
    const float* const* in; float* out; unsigned char* ws;
};
#define FIN(k) (F.in[k])

__device__ __forceinline__ void p0_mod(Frame& F) {
    LAS float* sil = (LAS float*)F.lds;
    LAS float* red = (LAS float*)(F.lds + 32768);
    for (int i = F.tid; i < 8 * D_; i += NTHR) sil[i] = silu_f(FIN(I_C)[i]);
    __syncthreads();
    float* mod = (float*)(F.ws + WS_MOD);
    const int c = F.lane & 31, kp = F.lane >> 5;
    for (int slice = F.vcu; slice < 256; slice += F.G) {
        const int col0 = slice * 24;
        float acc[8] = {0.f, 0.f, 0.f, 0.f, 0.f, 0.f, 0.f, 0.f};
        const float* wp = FIN(I_WADA) + (size_t)(128 * F.wave + kp) * 6144 + col0 + (c < 24 ? c : 0);
#pragma unroll 8
        for (int i = 0; i < 64; ++i) { const float wv = wp[(size_t)(2 * i) * 6144]; const int k = 128 * F.wave + kp + 2 * i;
#pragma unroll
            for (int b = 0; b < 8; ++b) acc[b] += sil[b * D_ + k] * wv; }
#pragma unroll
        for (int b = 0; b < 8; ++b) { acc[b] += __shfl_xor(acc[b], 32); if (F.lane < 24) red[(F.wave * 8 + b) * 24 + c] = acc[b]; }
        __syncthreads();
        if (F.tid < 192) { const int b = F.tid / 24, cc = F.tid % 24; float s = FIN(I_BADA)[col0 + cc];
#pragma unroll
            for (int w = 0; w < 8; ++w) s += red[(w * 8 + b) * 24 + cc];
            mod[b * 6144 + col0 + cc] = s; }
        __syncthreads();
    }
}
struct TrItem { const float* src; bf16_t* dst; int ldw, ldk; };
__device__ __forceinline__ void tr_load(const TrItem& it, f32x4 (&r)[8], int lane) {
#pragma unroll
    for (int i = 0; i < 8; ++i) r[i] = *(const f32x4*)(it.src + (size_t)(8 * i + (lane >> 3)) * it.ldw + 4 * (lane & 7));
}
__device__ __forceinline__ void tr_finish(const TrItem& it, const f32x4 (&r)[8], LAS float* scr, int lane) {
#pragma unroll
    for (int i = 0; i < 8; ++i) { LAS float* w = scr + (8 * i + (lane >> 3)) * 33 + 4 * (lane & 7); w[0] = r[i][0]; w[1] = r[i][1]; w[2] = r[i][2]; w[3] = r[i][3]; }
    LDS_WAIT(); asm volatile("" ::: "memory");
    const int c = lane & 7;
#pragma unroll
    for (int j = 0; j < 4; ++j) { const int n = (lane >> 3) + 8 * j; const LAS float* s = scr + (8 * c) * 33 + n;
        u32x4 o; o.x = pk2(s[0 * 33], s[1 * 33]); o.y = pk2(s[2 * 33], s[3 * 33]); o.z = pk2(s[4 * 33], s[5 * 33]); o.w = pk2(s[6 * 33], s[7 * 33]);
        *(u32x4*)(it.dst + (size_t)n * it.ldk + 8 * c) = o; }
    LDS_WAIT(); asm volatile("" ::: "memory");
}
#define TR_RUN(n_items, ITEM) do { f32x4 ra_[8], rb_[8]; int it_ = gw; TrItem ia_, ib_; \
    if (it_ < (n_items)) { ia_ = ITEM(it_); tr_load(ia_, ra_, F.lane); } \
    while (it_ < (n_items)) { const int nx_ = it_ + NGW; \
        if (nx_ < (n_items)) { ib_ = ITEM(nx_); tr_load(ib_, rb_, F.lane); } \
        tr_finish(ia_, ra_, scr, F.lane); it_ = nx_; \
        if (it_ >= (n_items)) break; \
        const int nx2_ = it_ + NGW; \
        if (nx2_ < (n_items)) { ia_ = ITEM(nx2_); tr_load(ia_, ra_, F.lane); } \
        tr_finish(ib_, rb_, scr, F.lane); it_ = nx2_; } } while (0)
__device__ __forceinline__ TrItem p0_item(Frame& F, int r) {
    constexpr int I_WINB = 16 * 184, I_A = 8 * 32, I_B = 4 * 32;
    TrItem t;
    if (r < I_WINB) { const int kb = r / 184, pcb = r % 184, pc0 = pcb * 32, sc0 = pc0 < SRC_FORGET ? pc0 : pc0 + 8;
        const int tile = pc0 >> 8, within = pc0 & 255, wc = within >> 6, bj = (within >> 5) & 1, row0 = tile * 256 + 128 * bj + 32 * wc;
        t.src = FIN(I_WIN) + (size_t)(64 * kb) * NIN + sc0; t.ldw = NIN; t.dst = (bf16_t*)(F.ws + WS_WIN) + (size_t)row0 * D_ + 64 * kb; t.ldk = D_; return t; }
    r -= I_WINB;
    if (r < I_A) { const int kb = r / 32, nb = r % 32; t.src = FIN(I_WBA) + (size_t)(64 * kb) * D_ + 32 * nb; t.ldw = D_; t.dst = (bf16_t*)(F.ws + WS_WA) + (size_t)(32 * nb) * 512 + 64 * kb; t.ldk = 512; return t; }
    r -= I_A;
    if (r < I_B) { const int kb = r / 32, nb = r % 32; t.src = FIN(I_WBB) + (size_t)(64 * kb) * D_ + 32 * nb; t.ldw = D_; t.dst = (bf16_t*)(F.ws + WS_WB) + (size_t)(32 * nb) * 256 + 64 * kb; t.ldk = 256; return t; }
    r -= I_B;
    { const int kb = r / 32, nb = r % 32; t.src = FIN(I_WOUT) + (size_t)(64 * kb) * D_ + 32 * nb; t.ldw = D_; t.dst = (bf16_t*)(F.ws + WS_WOUT) + (size_t)(32 * nb) * D_ + 64 * kb; t.ldk = D_; return t; }
}
__device__ __forceinline__ void p0_prologue(Frame& F) {
    LAS float* scr = (LAS float*)(F.lds + F.wave * 16384);
    const int gw = F.vcu * NWAVES + F.wave, NGW = F.G * NWAVES;
    p0_mod(F);
    constexpr int NITEMS = 16 * 184 + 8 * 32 + 4 * 32 + 16 * 32;
#define P0_ITEM(i) p0_item(F, (i))
    TR_RUN(NITEMS, P0_ITEM);
#undef P0_ITEM
}
__device__ __forceinline__ void p1_norm1(Frame& F) {
    LAS float* wf = (LAS float*)F.lds;
    for (int i = F.tid; i < 8 * D_; i += NTHR) { const int c = i >> 3, hh = i & 7; wf[hh * D_ + c] = FIN(I_WIN)[(size_t)c * NIN + SRC_FORGET + hh]; }
    __syncthreads();
    const int gw = F.vcu * NWAVES + F.wave, t0 = gw * 8, b = t0 / S_;
    const float* mod = (const float*)(F.ws + WS_MOD) + b * 6144;
    f32x4 gsc[4], shv[4];
#pragma unroll
    for (int j = 0; j < 4; ++j) { const int c = 4 * F.lane + 256 * j; const f32x4 g = *(const f32x4*)(FIN(I_N1G) + c), sc = *(const f32x4*)(mod + 1024 + c); gsc[j] = g * (sc + 1.f); shv[j] = *(const f32x4*)(mod + c); }
    bf16_t* H = (bf16_t*)(F.ws + WS_H); float* logf = (float*)(F.ws + WS_LOGF);
    f32x4 vn[4];
#pragma unroll
    for (int j = 0; j < 4; ++j) vn[j] = *(const f32x4*)(FIN(I_X) + (size_t)t0 * D_ + 4 * F.lane + 256 * j);
    for (int tt = 0; tt < 8; ++tt) { const int t = t0 + tt;
        f32x4 v[4]; float ss = 0.f;
#pragma unroll
        for (int j = 0; j < 4; ++j) { v[j] = vn[j]; ss += (v[j][0] * v[j][0] + v[j][1] * v[j][1]) + (v[j][2] * v[j][2] + v[j][3] * v[j][3]); }
        if (tt < 7) {
#pragma unroll
            for (int j = 0; j < 4; ++j) vn[j] = *(const f32x4*)(FIN(I_X) + (size_t)(t + 1) * D_ + 4 * F.lane + 256 * j); }
        const float rstd = rsqrtf(wave_sum(ss) * (1.f / D_) + EPS_);
        float z[8] = {0.f, 0.f, 0.f, 0.f, 0.f, 0.f, 0.f, 0.f};
#pragma unroll
        for (int j = 0; j < 4; ++j) { v[j] = v[j] * rstd * gsc[j] + shv[j];
            u32x2 o; o.x = pk2(v[j][0], v[j][1]); o.y = pk2(v[j][2], v[j][3]);
            *(u32x2*)(H + (size_t)t * D_ + 4 * F.lane + 256 * j) = o;
#pragma unroll
            for (int hh = 0; hh < 8; ++hh) { const f32x4 w = *(const LAS f32x4*)(wf + hh * D_ + 4 * F.lane + 256 * j); z[hh] += (v[j][0] * w[0] + v[j][1] * w[1]) + (v[j][2] * w[2] + v[j][3] * w[3]); } }
        wave_reduce8(z, F.lane);
        if (F.lane < 8) { float zz = z[0];
#pragma unroll
            for (int hh = 1; hh < 8; ++hh) zz = (F.lane == hh) ? z[hh] : zz;
            zz += FIN(I_BFORGET)[F.lane];
            logf[((size_t)b * 8 + F.lane) * S_ + (t - b * S_)] = fminf(zz, 0.f) - log1pf(__expf(-fabsf(zz))); }
    }
    __syncthreads();
}
__device__ __forceinline__ int crow(int r, int hi) { return (r & 3) + 8 * (r >> 2) + 4 * hi; }
typedef short v4i16_t __attribute__((ext_vector_type(4)));
__device__ __forceinline__ s16x4 vtr(const LAS unsigned char* p) { return __builtin_bit_cast(s16x4, __builtin_amdgcn_ds_read_tr16_b64_v4i16((LAS v4i16_t*)p)); }
__device__ __forceinline__ float half_swap_max(float m) { auto rr = __builtin_amdgcn_permlane32_swap(__float_as_uint(m), __float_as_uint(m), false, false); return fmaxf(__uint_as_float(rr[0]), __uint_as_float(rr[1])); }
__device__ __forceinline__ float half_swap_sum(float m) { auto rr = __builtin_amdgcn_permlane32_swap(__float_as_uint(m), __float_as_uint(m), false, false); return __uint_as_float(rr[0]) + __uint_as_float(rr[1]); }
__device__ __forceinline__ int vimg(int key, int cbyte) { return key * 128 + (cbyte ^ (((key >> 1) & 1) << 6)); }
__device__ __forceinline__ void pv_step(f32x16& o0, f32x16& o1, const LAS unsigned char* vrow16, int lane, bf16x8 pb) {
    const int hi = lane >> 5, i = lane & 15, g1 = (lane >> 4) & 1;
    const int kq = 4 * hi + (i >> 2);
    const int sw = ((kq >> 1) & 1) << 6;
    const int c0 = (32 * g1 + 8 * (i & 3));
    const LAS unsigned char* p0 = vrow16 + kq * 128;
    const s16x4 a0lo = vtr(p0 + ((c0) ^ sw)), a0hi = vtr(p0 + 8 * 128 + ((c0) ^ sw));
    const s16x4 a1lo = vtr(p0 + ((c0 + 64) ^ sw)), a1hi = vtr(p0 + 8 * 128 + ((c0 + 64) ^ sw));
    const bf16x8 A0 = {a0lo[0], a0lo[1], a0lo[2], a0lo[3], a0hi[0], a0hi[1], a0hi[2], a0hi[3]};
    const bf16x8 A1 = {a1lo[0], a1lo[1], a1lo[2], a1lo[3], a1hi[0], a1hi[1], a1hi[2], a1hi[3]};
    o0 = __builtin_amdgcn_mfma_f32_32x32x16_bf16(A0, pb, o0, 0, 0, 0);
    o1 = __builtin_amdgcn_mfma_f32_32x32x16_bf16(A1, pb, o1, 0, 0, 0);
}
__device__ __forceinline__ bf16x8 pack8(const f32x16& p, int b) {
    u32x4 w; w.x = pk2(p[b], p[b + 1]); w.y = pk2(p[b + 2], p[b + 3]); w.z = pk2(p[b + 4], p[b + 5]); w.w = pk2(p[b + 6], p[b + 7]);
    return __builtin_bit_cast(bf16x8, w);
}
__device__ __forceinline__ void store_ot(bf16_t* dst, const f32x16& o0, const f32x16& o1, float rl, int hi) {
#pragma unroll
    for (int i = 0; i < 4; ++i) {
        u32x2 a; a.x = pk2(o0[4 * i] * rl, o0[4 * i + 1] * rl); a.y = pk2(o0[4 * i + 2] * rl, o0[4 * i + 3] * rl);
        u32x2 b; b.x = pk2(o1[4 * i] * rl, o1[4 * i + 1] * rl); b.y = pk2(o1[4 * i + 2] * rl, o1[4 * i + 3] * rl);
        *(u32x2*)(dst + 8 * i + 4 * hi) = a; *(u32x2*)(dst + 32 + 8 * i + 4 * hi) = b; }
}

constexpr int DIL_TBL_OFF = 8 * 4096;
constexpr float NEG_BIG = -30000.f;
__device__ __forceinline__ void p3a_dilated(Frame& F) {
    LAS float* tbl = (LAS float*)(F.lds + DIL_TBL_OFF);
    for (int i = F.tid; i < 12 * 192; i += NTHR) { const int hd = i / 192, x = i % 192, m = 159 - x, g = hd >> 2, d = (g == 0) ? 1 : (g == 1 ? 4 : 16); (void)d;
        tbl[i] = (m >= 0 && m <= 128) ? FIN(I_TABLE)[T5BUCKET[g][m] * 12 + hd] * LOG2E : NEG_BIG; }
    __syncthreads();
    const bf16_t* P = (const bf16_t*)(F.ws + WS_PROJ);
    bf16_t* OG = (bf16_t*)(F.ws + WS_OG); float* LSE = (float*)(F.ws + WS_LSE);
    LAS unsigned char* vbuf = F.lds + F.wave * 4096;
    const int lane = F.lane, r32 = lane & 31, hi = lane >> 5;
    for (int unit = F.vcu; unit < 768; unit += F.G) {
        const int task = unit * 8 + F.wave, bh = task >> 6, j = task & 63, b = bh / 12, hd = bh % 12, g = hd >> 2, slot = hd & 3;
        int d, r, qt;
        if (g == 0) { d = 1; r = 0; qt = j; } else if (g == 1) { d = 4; r = j >> 4; qt = j & 15; } else { d = 16; r = j >> 2; qt = j & 3; }
        const size_t rowb = (size_t)b * S_;
        const int n0 = 32 * qt;
        const bf16_t* qrow = P + (rowb + (size_t)(n0 + r32) * d + r) * NP + PC_DQ + hd * 64 + 8 * hi;
        bf16x8 qf[4];
#pragma unroll
        for (int s = 0; s < 4; ++s) qf[s] = *(const bf16x8*)(qrow + 16 * s);
        float m_run = -1e30f, l_run = 0.f; f32x16 o0 = {}, o1 = {};
        const LAS float* tb = tbl + hd * 192;
        for (int kt = qt; kt >= 0 && kt >= qt - 4; --kt) {
            const int k0 = 32 * kt;
            const bf16_t* krow = P + (rowb + (size_t)(k0 + r32) * d + r) * NP + PC_DK + hd * 64 + 8 * hi;
            bf16x8 kf[4];
#pragma unroll
            for (int s = 0; s < 4; ++s) kf[s] = *(const bf16x8*)(krow + 16 * s);
            u32x4 vr[4];
#pragma unroll
            for (int i = 0; i < 4; ++i) { const int row = (lane >> 3) + 8 * i; vr[i] = *(const u32x4*)(P + (rowb + (size_t)(k0 + row) * d + r) * NP + PC_DV + hd * 64 + (lane & 7) * 8); }
            f32x16 sc = {};
#pragma unroll
            for (int s = 0; s < 4; ++s) sc = __builtin_amdgcn_mfma_f32_32x32x16_bf16(kf[s], qf[s], sc, 0, 0, 0);
            const LAS float* tp = tb + (159 - 32 * (qt - kt) - r32 + 4 * hi);
            float mx = -1e30f;
#pragma unroll
            for (int rg = 0; rg < 16; ++rg) { sc[rg] += tp[(rg & 3) + 8 * (rg >> 2)]; mx = fmaxf(mx, sc[rg]); }
            mx = half_swap_max(mx);
            const float mn = fmaxf(m_run, mx), alpha = __builtin_amdgcn_exp2f(m_run - mn); m_run = mn;
            float ls = 0.f;
#pragma unroll
            for (int rg = 0; rg < 16; ++rg) { sc[rg] = __builtin_amdgcn_exp2f(sc[rg] - mn); ls += sc[rg]; }
            l_run = l_run * alpha + ls;
#pragma unroll
            for (int rg = 0; rg < 16; ++rg) { o0[rg] *= alpha; o1[rg] *= alpha; }
            const bf16x8 pb0 = pack8(sc, 0), pb1 = pack8(sc, 8);
#pragma unroll
            for (int i = 0; i < 4; ++i) { const int row = (lane >> 3) + 8 * i; *(LAS u32x4*)(vbuf + vimg(row, (lane & 7) * 16)) = vr[i]; }
            LDS_WAIT(); asm volatile("" ::: "memory");
            pv_step(o0, o1, vbuf, lane, pb0);
            pv_step(o0, o1, vbuf + 16 * 128, lane, pb1);
            LDS_WAIT(); asm volatile("" ::: "memory");
        }
        const float lt = half_swap_sum(l_run), rl = __builtin_amdgcn_rcpf(lt);
        const size_t tok = rowb + (size_t)(n0 + r32) * d + r;
        store_ot(OG + ((size_t)g * T_ + tok) * 256 + slot * 64, o0, o1, rl, hi);
        if (hi == 0) LSE[((size_t)g * T_ + tok) * 4 + slot] = m_run + __builtin_amdgcn_logf(lt);
    }
    __syncthreads();
}

constexpr int FOX_K_OFF = 0, FOX_V_OFF = 16384, FOX_CUM_OFF = 32768;
__device__ __forceinline__ int kimg(int key, int chunk) { return key * 128 + ((chunk ^ ((key >> 1) & 7)) << 4); }
__device__ __forceinline__ void fox_unit(Frame& F, int b, int h, int qb) {
    const bf16_t* P = (const bf16_t*)(F.ws + WS_PROJ);
    const float* logf = (const float*)(F.ws + WS_LOGF) + ((size_t)b * 8 + h) * S_;
    LAS float* ncum = (LAS float*)(F.lds + FOX_CUM_OFF);
    const int lane = F.lane, r32 = lane & 31, hi = lane >> 5, tid = F.tid;
    const int nkeys = 256 * (qb + 1), nt = nkeys / 64;
    if (F.wave == 0) {
        const int per = nkeys / 64; float run = 0.f; float loc[32];
#pragma unroll
        for (int i = 0; i < 32; ++i) { const float v = (i < per) ? logf[lane * per + i] : 0.f; run += v; loc[i] = run; }
        float incl = run;
#pragma unroll
        for (int o = 1; o < 64; o <<= 1) { const float t = __shfl_up(incl, o); if (lane >= o) incl += t; }
        const float base = incl - run;
#pragma unroll
        for (int i = 0; i < 32; ++i) if (i < per) ncum[lane * per + i] = -(base + loc[i]) * LOG2E;
    }
    const size_t rowb = (size_t)b * S_;
    const int srow = tid >> 3, sch = tid & 7;
    const bf16_t* kg = P + (rowb + srow) * NP + PC_FK + h * 64 + sch * 8;
    const bf16_t* vg = P + (rowb + srow) * NP + PC_FV + h * 64 + sch * 8;
    u32x4 kst = *(const u32x4*)kg, vst = *(const u32x4*)vg;
    const int q0w = qb * 256 + F.wave * 32;
    const bf16_t* qrow = P + (rowb + q0w + r32) * NP + PC_FQ + h * 64 + 8 * hi;
    bf16x8 qf[4];
#pragma unroll
    for (int s = 0; s < 4; ++s) qf[s] = *(const bf16x8*)(qrow + 16 * s);
    *(LAS u32x4*)(F.lds + FOX_K_OFF + kimg(srow, sch)) = kst;
    *(LAS u32x4*)(F.lds + FOX_V_OFF + vimg(srow, sch * 16)) = vst;
    __syncthreads();
    float m_run = -1e30f, l_run = 0.f; f32x16 o0 = {}, o1 = {};
    for (int t = 0; t < nt; ++t) {
        const int cur = t & 1;
        if (t + 1 < nt) { kst = *(const u32x4*)(kg + (size_t)(t + 1) * 64 * NP); vst = *(const u32x4*)(vg + (size_t)(t + 1) * 64 * NP); }
        const int k0 = 64 * t;
        if (k0 <= q0w + 31) {
            const LAS unsigned char* kb = F.lds + FOX_K_OFF + cur * 8192;
            const LAS unsigned char* vb = F.lds + FOX_V_OFF + cur * 8192;
            f32x16 s0 = {}, s1 = {};
#pragma unroll
            for (int s = 0; s < 4; ++s) {
                const bf16x8 ka = *(const LAS bf16x8*)(kb + kimg(r32, 2 * s + hi));
                const bf16x8 kc = *(const LAS bf16x8*)(kb + kimg(32 + r32, 2 * s + hi));
                s0 = __builtin_amdgcn_mfma_f32_32x32x16_bf16(ka, qf[s], s0, 0, 0, 0);
                s1 = __builtin_amdgcn_mfma_f32_32x32x16_bf16(kc, qf[s], s1, 0, 0, 0);
            }
            const LAS float* nc = ncum + k0 + 4 * hi;
#pragma unroll
            for (int i = 0; i < 4; ++i) { const f32x4 c0 = *(const LAS f32x4*)(nc + 8 * i), c1 = *(const LAS f32x4*)(nc + 32 + 8 * i);
#pragma unroll
                for (int jj = 0; jj < 4; ++jj) { s0[4 * i + jj] += c0[jj]; s1[4 * i + jj] += c1[jj]; } }
            if (k0 + 63 > q0w) {
                const int q = q0w + r32;
#pragma unroll
                for (int rg = 0; rg < 16; ++rg) { const int key = k0 + crow(rg, hi); if (key > q) s0[rg] = -1e30f; if (key + 32 > q) s1[rg] = -1e30f; }
            }
            float mx = -1e30f;
#pragma unroll
            for (int rg = 0; rg < 16; ++rg) mx = fmaxf(mx, fmaxf(s0[rg], s1[rg]));
            mx = half_swap_max(mx);
            const float mn = fmaxf(m_run, mx), alpha = __builtin_amdgcn_exp2f(m_run - mn); m_run = mn;
            float ls = 0.f;
#pragma unroll
            for (int rg = 0; rg < 16; ++rg) { s0[rg] = __builtin_amdgcn_exp2f(s0[rg] - mn); s1[rg] = __builtin_amdgcn_exp2f(s1[rg] - mn); ls += s0[rg] + s1[rg]; }
            l_run = l_run * alpha + ls;
#pragma unroll
            for (int rg = 0; rg < 16; ++rg) { o0[rg] *= alpha; o1[rg] *= alpha; }
            pv_step(o0, o1, vb, lane, pack8(s0, 0));
            pv_step(o0, o1, vb + 16 * 128, lane, pack8(s0, 8));
            pv_step(o0, o1, vb + 32 * 128, lane, pack8(s1, 0));
            pv_step(o0, o1, vb + 48 * 128, lane, pack8(s1, 8));
        }
        if (t + 1 < nt) {
            *(LAS u32x4*)(F.lds + FOX_K_OFF + (cur ^ 1) * 8192 + kimg(srow, sch)) = kst;
            *(LAS u32x4*)(F.lds + FOX_V_OFF + (cur ^ 1) * 8192 + vimg(srow, sch * 16)) = vst;
        }
        __syncthreads();
    }
    const float lt = half_swap_sum(l_run), rl = __builtin_amdgcn_rcpf(lt);
    store_ot((bf16_t*)(F.ws + WS_YA) + (rowb + q0w + r32) * 512 + h * 64, o0, o1, rl, hi);
}
__device__ __forceinline__ void combine_token(Frame& F, int t) {
    const bf16_t* OG = (const bf16_t*)(F.ws + WS_OG); const float* LSE = (const float*)(F.ws + WS_LSE);
    const int c = 4 * F.lane, slot = F.lane >> 4;
    float l0 = LSE[((size_t)0 * T_ + t) * 4 + slot], l1 = LSE[((size_t)1 * T_ + t) * 4 + slot], l2 = LSE[((size_t)2 * T_ + t) * 4 + slot];
    const float mx = fmaxf(l0, fmaxf(l1, l2)); l0 = __builtin_amdgcn_exp2f(l0 - mx); l1 = __builtin_amdgcn_exp2f(l1 - mx); l2 = __builtin_amdgcn_exp2f(l2 - mx);
    const float r = __builtin_amdgcn_rcpf(l0 + l1 + l2); l0 *= r; l1 *= r; l2 *= r;
    const u32x2 a = *(const u32x2*)(OG + ((size_t)0 * T_ + t) * 256 + c), bq = *(const u32x2*)(OG + ((size_t)1 * T_ + t) * 256 + c), cq = *(const u32x2*)(OG + ((size_t)2 * T_ + t) * 256 + c);
    auto lo = [](unsigned w) { return __uint_as_float(w << 16); }; auto hi16 = [](unsigned w) { return __uint_as_float(w & 0xffff0000u); };
    u32x2 o;
    o.x = pk2(l0 * lo(a.x) + l1 * lo(bq.x) + l2 * lo(cq.x), l0 * hi16(a.x) + l1 * hi16(bq.x) + l2 * hi16(cq.x));
    o.y = pk2(l0 * lo(a.y) + l1 * lo(bq.y) + l2 * lo(cq.y), l0 * hi16(a.y) + l1 * hi16(bq.y) + l2 * hi16(cq.y));
    *(u32x2*)((bf16_t*)(F.ws + WS_YD) + (size_t)t * 256 + c) = o;
}
__device__ __forceinline__ void p3b_fox(Frame& F) {
    for (int u = F.vcu; u < 256; u += F.G) {
        const int bh = u >> 2, p = u & 3;
        fox_unit(F, bh >> 3, bh & 7, 7 - p);
        fox_unit(F, bh >> 3, bh & 7, p);
    }
    const int gw = F.vcu * NWAVES + F.wave, NGW = F.G * NWAVES;
    for (int t = gw; t < T_; t += NGW) combine_token(F, t);
}
__device__ __forceinline__ TrItem p7_item(Frame& F, int it) {
    TrItem t;
    if (it < 16384) { const int e = it >> 9, r = it & 511, mat = r >> 8, r2 = r & 255, kb = r2 >> 4, nb = r2 & 15, hc0 = 32 * nb, row = (hc0 >> 7) * 256 + mat * 128 + (hc0 & 127);
        t.src = FIN(mat ? I_W3 : I_W1) + (size_t)e * D_ * EH + (size_t)(64 * kb) * EH + hc0; t.ldw = EH; t.dst = (bf16_t*)(F.ws + WS_W13) + ((size_t)e * 1024 + row) * D_ + 64 * kb; t.ldk = D_; }
    else { const int r = it - 16384, e = r >> 8, r2 = r & 255, kb = r2 >> 5, nb = r2 & 31;
        t.src = FIN(I_W2) + (size_t)e * EH * D_ + (size_t)(64 * kb) * D_ + 32 * nb; t.ldw = D_; t.dst = (bf16_t*)(F.ws + WS_W2T) + ((size_t)e * 1024 + 32 * nb) * EH + 64 * kb; t.ldk = EH; }
    return t;
}
__device__ __forceinline__ void p7_convert(Frame& F) {
    {   LAS float* scr = (LAS float*)(F.lds + F.wave * 16384);
        const int gw = F.vcu * NWAVES + F.wave, NGW = F.G * NWAVES;
#define P7_ITEM(i) p7_item(F, (i))
        TR_RUN(24576, P7_ITEM);
#undef P7_ITEM
    }
    __syncthreads();
}
__device__ __forceinline__ void p7_norm2_router(Frame& F, bool commit) {
    volatile LAS unsigned* LC = (volatile LAS unsigned*)(F.lds + LDS_CTL);
    constexpr int WTS = 1028;
    LAS float* wT = (LAS float*)F.lds;
    for (int i = F.tid; i < 4 * D_; i += NTHR) { const int c = i >> 2, e = i & 3; wT[e * WTS + c] = FIN(I_WRG)[i]; }
    for (int i = F.tid; i < 32 * D_; i += NTHR) { const int c = i >> 5, e = i & 31; wT[(4 + e) * WTS + c] = FIN(I_WRE)[i]; }
    if (F.tid < 32) LC[LC_CNT + F.tid] = 0u;
    __syncthreads();
    const int gw = F.vcu * NWAVES + F.wave, t0 = gw * 8, b = t0 / S_;
    const float* mod = (const float*)(F.ws + WS_MOD) + b * 6144;
    f32x4 gsc[4], shv[4];
#pragma unroll
    for (int j = 0; j < 4; ++j) { const int c = 4 * F.lane + 256 * j; const f32x4 g = *(const f32x4*)(FIN(I_N2G) + c), sc = *(const f32x4*)(mod + 4096 + c); gsc[j] = g * (sc + 1.f); shv[j] = *(const f32x4*)(mod + 3072 + c); }
    bf16_t* H2 = (bf16_t*)(F.ws + WS_H); int* toke = (int*)(F.ws + WS_TOKE); float* tokw = (float*)(F.ws + WS_TOKW);
    f32x4 vn[4];
#pragma unroll
    for (int j = 0; j < 4; ++j) vn[j] = *(const f32x4*)(F.out + (size_t)t0 * D_ + 4 * F.lane + 256 * j);
    for (int tt = 0; tt < 8; ++tt) { const int t = t0 + tt;
        f32x4 v[4]; float ss = 0.f;
#pragma unroll
        for (int j = 0; j < 4; ++j) { v[j] = vn[j]; ss += (v[j][0] * v[j][0] + v[j][1] * v[j][1]) + (v[j][2] * v[j][2] + v[j][3] * v[j][3]); }
        if (tt < 7) {
#pragma unroll
            for (int j = 0; j < 4; ++j) vn[j] = *(const f32x4*)(F.out + (size_t)(t + 1) * D_ + 4 * F.lane + 256 * j); }
        const float rstd = rsqrtf(wave_sum(ss) * (1.f / D_) + EPS_);
        float gl[4] = {0.f, 0.f, 0.f, 0.f};
#pragma unroll
        for (int j = 0; j < 4; ++j) { v[j] = v[j] * rstd * gsc[j] + shv[j];
            u32x2 o; o.x = pk2(v[j][0], v[j][1]); o.y = pk2(v[j][2], v[j][3]);
            *(u32x2*)(H2 + (size_t)t * D_ + 4 * F.lane + 256 * j) = o;
#pragma unroll
            for (int g = 0; g < 4; ++g) { const f32x4 w = *(const LAS f32x4*)(wT + g * WTS + 4 * F.lane + 256 * j); gl[g] += (v[j][0] * w[0] + v[j][1] * w[1]) + (v[j][2] * w[2] + v[j][3] * w[3]); } }
        wave_reduce4(gl, F.lane);
        int gi = 0; float gm = -1e30f, gs = 0.f;
#pragma unroll
        for (int g = 0; g < 4; ++g) { gl[g] += FIN(I_BRG)[g]; if (gl[g] > gm) { gm = gl[g]; gi = g; } }
#pragma unroll
        for (int g = 0; g < 4; ++g) gs += __expf(gl[g] - gm);
        gi = __builtin_amdgcn_readfirstlane(gi);
        const float gwt = 1.f / gs;
        float el[8] = {0.f, 0.f, 0.f, 0.f, 0.f, 0.f, 0.f, 0.f};
        const LAS float* we = wT + (4 + gi * 8) * WTS;
#pragma unroll
        for (int j = 0; j < 4; ++j)
#pragma unroll
            for (int e = 0; e < 8; ++e) { const f32x4 w = *(const LAS f32x4*)(we + e * WTS + 4 * F.lane + 256 * j); el[e] += (v[j][0] * w[0] + v[j][1] * w[1]) + (v[j][2] * w[2] + v[j][3] * w[3]); }
        wave_reduce8(el, F.lane);
        int i0 = 0, i1 = 0; float v0 = -1e30f, v1 = -1e30f;
#pragma unroll
        for (int e = 0; e < 8; ++e) { el[e] += FIN(I_BRE)[gi * 8 + e];
            if (el[e] > v0) { v1 = v0; i1 = i0; v0 = el[e]; i0 = e; } else if (el[e] > v1) { v1 = el[e]; i1 = e; } }
        const float e1 = __expf(v1 - v0), w0 = gwt / (1.f + e1), w1 = gwt * e1 / (1.f + e1);
        if (F.lane == 0) { const int ea = gi * 8 + i0, eb = gi * 8 + i1; toke[t * 2] = ea; toke[t * 2 + 1] = eb; tokw[t * 2] = w0; tokw[t * 2 + 1] = w1;
            __hip_atomic_fetch_add((LAS unsigned*)(LC + LC_CNT + ea), 1u, __ATOMIC_RELAXED, __HIP_MEMORY_SCOPE_WORKGROUP);
            __hip_atomic_fetch_add((LAS unsigned*)(LC + LC_CNT + eb), 1u, __ATOMIC_RELAXED, __HIP_MEMORY_SCOPE_WORKGROUP); }
    }
    __syncthreads();
    if (F.tid < 32 && commit) { const unsigned n = LC[LC_CNT + F.tid]; if (n) __hip_atomic_fetch_add((unsigned*)(F.ws + WS_CTL) + CW_CNT + F.tid, n, __ATOMIC_RELAXED, __HIP_MEMORY_SCOPE_AGENT); }
    __syncthreads();
}
__device__ __forceinline__ void moe_tile_starts(Frame& F) {
    volatile LAS unsigned* LC = (volatile LAS unsigned*)(F.lds + LDS_CTL);
    if (F.tid == 0) { const unsigned* cnt = (const unsigned*)(F.ws + WS_CTL) + CW_CNT; unsigned acc = 0;
        for (int e = 0; e < 32; ++e) { LC[LC_TST + e] = acc; acc += (__hip_atomic_load(cnt + e, __ATOMIC_RELAXED, __HIP_MEMORY_SCOPE_AGENT) + 255u) >> 8; }
        LC[LC_TST + 32] = acc; }
    __syncthreads();
}
__device__ __forceinline__ void p8_dispatch(Frame& F) {
    volatile LAS unsigned* LC = (volatile LAS unsigned*)(F.lds + LDS_CTL);
    if (F.tid < 32) LC[LC_CNT + F.tid] = 0u;
    moe_tile_starts(F);
    const int gw = F.vcu * NWAVES + F.wave, t0 = gw * 8;
    const int* toke = (const int*)(F.ws + WS_TOKE); int* tokpos = (int*)(F.ws + WS_TOKPOS);
    int e = 0; unsigned rk = 0;
    if (F.lane < 16) { e = toke[t0 * 2 + F.lane]; rk = __hip_atomic_fetch_add((LAS unsigned*)(LC + LC_CNT + e), 1u, __ATOMIC_RELAXED, __HIP_MEMORY_SCOPE_WORKGROUP); }
    __syncthreads();
    if (F.tid < 32) { const unsigned n = LC[LC_CNT + F.tid];
        LC[LC_BASE + F.tid] = n ? __hip_atomic_fetch_add((unsigned*)(F.ws + WS_CTL) + CW_CUR + F.tid, n, __ATOMIC_RELAXED, __HIP_MEMORY_SCOPE_AGENT) : 0u; }
    __syncthreads();
    int pos = 0;
    if (F.lane < 16) { pos = (int)(LC[LC_TST + e] * 256u + LC[LC_BASE + e] + rk); tokpos[t0 * 2 + F.lane] = pos; }
    const bf16_t* H2 = (const bf16_t*)(F.ws + WS_H); bf16_t* XS = (bf16_t*)(F.ws + WS_XS);
#pragma unroll 4
    for (int idx = 0; idx < 16; ++idx) { const int p = __shfl(pos, idx); const u32x4* src = (const u32x4*)(H2 + (size_t)(t0 + (idx >> 1)) * D_); u32x4* dst = (u32x4*)(XS + (size_t)p * D_);
        dst[F.lane] = src[F.lane]; dst[F.lane + 64] = src[F.lane + 64]; }
    __syncthreads();
}
__device__ __forceinline__ void p11_final(Frame& F) {
    const int gw = F.vcu * NWAVES + F.wave, t0 = gw * 8, b = t0 / S_;
    const float* g2 = (const float*)(F.ws + WS_MOD) + b * 6144 + 5120;
    const int* tokpos = (const int*)(F.ws + WS_TOKPOS); const float* tokw = (const float*)(F.ws + WS_TOKW); const bf16_t* Y = (const bf16_t*)(F.ws + WS_XS);
    f32x4 gv[4];
#pragma unroll
    for (int j = 0; j < 4; ++j) gv[j] = *(const f32x4*)(g2 + 4 * F.lane + 256 * j);
    f32x4 xn[4];
#pragma unroll
    for (int j = 0; j < 4; ++j) xn[j] = *(const f32x4*)(F.out + (size_t)t0 * D_ + 4 * F.lane + 256 * j);
    int p0n = tokpos[t0 * 2], p1n = tokpos[t0 * 2 + 1]; float w0n = tokw[t0 * 2], w1n = tokw[t0 * 2 + 1];
    for (int tt = 0; tt < 8; ++tt) { const int t = t0 + tt; const int p0 = p0n, p1 = p1n; const float w0 = w0n, w1 = w1n;
        f32x4 xv[4]; u32x2 ya[4], yb[4];
#pragma unroll
        for (int j = 0; j < 4; ++j) { const int c = 4 * F.lane + 256 * j; xv[j] = xn[j]; ya[j] = *(const u32x2*)(Y + (size_t)p0 * D_ + c); yb[j] = *(const u32x2*)(Y + (size_t)p1 * D_ + c); }
        if (tt < 7) { p0n = tokpos[t * 2 + 2]; p1n = tokpos[t * 2 + 3]; w0n = tokw[t * 2 + 2]; w1n = tokw[t * 2 + 3];
#pragma unroll
            for (int j = 0; j < 4; ++j) xn[j] = *(const f32x4*)(F.out + (size_t)(t + 1) * D_ + 4 * F.lane + 256 * j); }
#pragma unroll
        for (int j = 0; j < 4; ++j) { const int c = 4 * F.lane + 256 * j; const u32x2 a = ya[j], bq = yb[j];
            f32x4 y; y[0] = w0 * __uint_as_float(a.x << 16) + w1 * __uint_as_float(bq.x << 16); y[1] = w0 * __uint_as_float(a.x & 0xffff0000u) + w1 * __uint_as_float(bq.x & 0xffff0000u);
            y[2] = w0 * __uint_as_float(a.y << 16) + w1 * __uint_as_float(bq.y << 16); y[3] = w0 * __uint_as_float(a.y & 0xffff0000u) + w1 * __uint_as_float(bq.y & 0xffff0000u);
            *(f32x4*)(F.out + (size_t)t * D_ + c) = xv[j] + gv[j] * y; }
    }
}
#ifndef MK_REP
#define MK_REP (-1)
#endif
#ifndef MK_ONLY
#define MK_ONLY (-1)
#endif
#define PH_ON(k) (MK_ONLY < 0 || MK_ONLY == (k))
__global__ void __launch_bounds__(NTHR, 2) fwd(Args args) {
    extern __shared__ __attribute__((aligned(16))) unsigned char lds_raw[];
    Frame F;
    F.lds = (LAS unsigned char*)lds_raw; F.ldsg = lds_raw;
    F.tid = threadIdx.x; F.lane = F.tid & 63; F.wave = __builtin_amdgcn_readfirstlane(F.tid >> 6);
    F.G = gridDim.x; { const int bx = blockIdx.x; F.vcu = (F.G % 8 == 0) ? (bx % 8) * (F.G / 8) + bx / 8 : bx; }
    F.in = args.in; F.out = args.out; F.ws = args.ws;
    volatile LAS unsigned* LC = (volatile LAS unsigned*)(F.lds + LDS_CTL);
    for (int u = F.tid; u < 256; u += NTHR) LC[u] = 0u;
    __syncthreads();
    unsigned* ctl = (unsigned*)(F.ws + WS_CTL);
    const int lo = args.ph_lo, hi = args.ph_hi;
    const bool multi = (hi - lo) > 1;
    XcdBarrier bar; bar.bar = ctl + CW_BAR + args.li * XCD_BAR_WORDS; bar.x = 0; bar.st = nullptr;
    if (multi) bar = xcd_barrier_post(ctl + CW_BAR + args.li * XCD_BAR_WORDS, LC + LC_BAR);
#define IN(k) (lo <= (k) && (k) < hi)
#define SEAM(k) do { if (IN(k) && IN((k) + 1)) xcd_barrier(bar); } while (0)
#if MK_REP == 0
    if (PH_ON(0) && IN(0)) { p0_prologue(F); }
#endif
    if (PH_ON(0) && IN(0)) { p0_prologue(F); } SEAM(0);
#if MK_REP == 1
    if (PH_ON(1) && IN(1)) { p1_norm1(F); }
#endif
    if (PH_ON(1) && IN(1)) { p1_norm1(F); } SEAM(1);
#if MK_REP == 2
    if (PH_ON(2) && IN(2)) {
        pg8::Gemm g{(const char*)(F.ws + WS_H), (const char*)(F.ws + WS_WIN), D_ * 2, D_ * 2, D_};
        pg8::DenseOrder S; S.init(T_, NP, F.G, (int)blockIdx.x, g.lda, g.ldb);
        pg8::EpiProj E{(bf16_t*)(F.ws + WS_PROJ), FIN(I_QGAIN), FIN(I_KGAIN)};
        pg8::gemm_phase<pg8::EpiProj, pg8::DenseOrder, true>(F.lds, g, S, E);
    }
#endif
    if (PH_ON(2) && IN(2)) {
        pg8::Gemm g{(const char*)(F.ws + WS_H), (const char*)(F.ws + WS_WIN), D_ * 2, D_ * 2, D_};
        pg8::DenseOrder S; S.init(T_, NP, F.G, (int)blockIdx.x, g.lda, g.ldb);
        pg8::EpiProj E{(bf16_t*)(F.ws + WS_PROJ), FIN(I_QGAIN), FIN(I_KGAIN)};
        pg8::gemm_phase<pg8::EpiProj, pg8::DenseOrder, true>(F.lds, g, S, E);
    } SEAM(2);
#if MK_REP == 3
    if (PH_ON(3) && IN(3)) { p3a_dilated(F); }
#endif
    if (PH_ON(3) && IN(3)) { p3a_dilated(F); } SEAM(3);
#if MK_REP == 4
    if (PH_ON(4) && IN(4)) { p3b_fox(F); }
#endif
    if (PH_ON(4) && IN(4)) { p3b_fox(F); } SEAM(4);
#if MK_REP == 5
    if (PH_ON(5) && IN(5)) {
        { pg8::Gemm g{(const char*)(F.ws + WS_YA), (const char*)(F.ws + WS_WA), 512 * 2, 512 * 2, 512};
          pg8::DenseOrder S; S.init(T_, D_, F.G, (int)blockIdx.x, g.lda, g.ldb);
          pg8::EpiBranch<0> E{(bf16_t*)(F.ws + WS_H), (const bf16_t*)(F.ws + WS_PROJ)};
          pg8::gemm_phase<pg8::EpiBranch<0>, pg8::DenseOrder, false>(F.lds, g, S, E); }
        { pg8::Gemm g{(const char*)(F.ws + WS_YD), (const char*)(F.ws + WS_WB), 256 * 2, 256 * 2, 256};
          pg8::DenseOrder S; S.init(T_, D_, F.G, (int)blockIdx.x, g.lda, g.ldb);
          pg8::EpiBranch<1> E{(bf16_t*)(F.ws + WS_H), (const bf16_t*)(F.ws + WS_PROJ)};
          pg8::gemm_phase<pg8::EpiBranch<1>, pg8::DenseOrder, false>(F.lds, g, S, E); }
    }
#endif
    if (PH_ON(5) && IN(5)) {
        { pg8::Gemm g{(const char*)(F.ws + WS_YA), (const char*)(F.ws + WS_WA), 512 * 2, 512 * 2, 512};
          pg8::DenseOrder S; S.init(T_, D_, F.G, (int)blockIdx.x, g.lda, g.ldb);
          pg8::EpiBranch<0> E{(bf16_t*)(F.ws + WS_H), (const bf16_t*)(F.ws + WS_PROJ)};
          pg8::gemm_phase<pg8::EpiBranch<0>, pg8::DenseOrder, false>(F.lds, g, S, E); }
        { pg8::Gemm g{(const char*)(F.ws + WS_YD), (const char*)(F.ws + WS_WB), 256 * 2, 256 * 2, 256};
          pg8::DenseOrder S; S.init(T_, D_, F.G, (int)blockIdx.x, g.lda, g.ldb);
          pg8::EpiBranch<1> E{(bf16_t*)(F.ws + WS_H), (const bf16_t*)(F.ws + WS_PROJ)};
          pg8::gemm_phase<pg8::EpiBranch<1>, pg8::DenseOrder, false>(F.lds, g, S, E); }
    } SEAM(5);
#if MK_REP == 6
    if (PH_ON(6) && IN(6)) {
        pg8::Gemm g{(const char*)(F.ws + WS_H), (const char*)(F.ws + WS_WOUT), D_ * 2, D_ * 2, D_};
        pg8::DenseOrder S; S.init(T_, D_, F.G, (int)blockIdx.x, g.lda, g.ldb);
        pg8::EpiOut E{F.out, FIN(I_X), (const float*)(F.ws + WS_MOD)};
        pg8::gemm_phase<pg8::EpiOut, pg8::DenseOrder, false>(F.lds, g, S, E);
    }
#endif
    if (PH_ON(6) && IN(6)) {
        pg8::Gemm g{(const char*)(F.ws + WS_H), (const char*)(F.ws + WS_WOUT), D_ * 2, D_ * 2, D_};
        pg8::DenseOrder S; S.init(T_, D_, F.G, (int)blockIdx.x, g.lda, g.ldb);
        pg8::EpiOut E{F.out, FIN(I_X), (const float*)(F.ws + WS_MOD)};
        pg8::gemm_phase<pg8::EpiOut, pg8::DenseOrder, false>(F.lds, g, S, E);
    } SEAM(6);
#if MK_REP == 70
    if (PH_ON(7) && IN(7)) { p7_convert(F); }
#endif
#if MK_REP == 71
    if (PH_ON(7) && IN(7)) { p7_norm2_router(F, false); }
#endif
    if (PH_ON(7) && IN(7)) { p7_convert(F); p7_norm2_router(F, true); } SEAM(7);
#if MK_REP == 8
    if (PH_ON(8) && IN(8)) { p8_dispatch(F); }
#endif
    if (PH_ON(8) && IN(8)) { p8_dispatch(F); } SEAM(8);
#if MK_REP == 9
    if (PH_ON(9) && IN(9)) {
        moe_tile_starts(F);
        pg8::Gemm g{(const char*)(F.ws + WS_XS), (const char*)(F.ws + WS_W13), D_ * 2, D_ * 2, D_};
        pg8::MoeOrder S{(const volatile LAS int*)(LC + LC_TST), (int)LC[LC_TST + 32] * 4, F.G, F.vcu, 256u * g.lda, 256u * g.ldb, 1024u * g.ldb};
        pg8::EpiGateUp E{(bf16_t*)(F.ws + WS_HID)};
        pg8::gemm_phase<pg8::EpiGateUp, pg8::MoeOrder, true>(F.lds, g, S, E);
    }
#endif
    if (PH_ON(9) && IN(9)) {
        moe_tile_starts(F);
        pg8::Gemm g{(const char*)(F.ws + WS_XS), (const char*)(F.ws + WS_W13), D_ * 2, D_ * 2, D_};
        pg8::MoeOrder S{(const volatile LAS int*)(LC + LC_TST), (int)LC[LC_TST + 32] * 4, F.G, F.vcu, 256u * g.lda, 256u * g.ldb, 1024u * g.ldb};
        pg8::EpiGateUp E{(bf16_t*)(F.ws + WS_HID)};
        pg8::gemm_phase<pg8::EpiGateUp, pg8::MoeOrder, true>(F.lds, g, S, E);
    } SEAM(9);
#if MK_REP == 10
    if (PH_ON(10) && IN(10)) {
        moe_tile_starts(F);
        pg8::Gemm g{(const char*)(F.ws + WS_HID), (const char*)(F.ws + WS_W2T), EH * 2, EH * 2, EH};
        pg8::MoeOrder S{(const volatile LAS int*)(LC + LC_TST), (int)LC[LC_TST + 32] * 4, F.G, F.vcu, 256u * g.lda, 256u * g.ldb, 1024u * g.ldb};
        pg8::EpiBf16 E{(bf16_t*)(F.ws + WS_XS), D_};
        pg8::gemm_phase<pg8::EpiBf16, pg8::MoeOrder, true>(F.lds, g, S, E);
    }
#endif
    if (PH_ON(10) && IN(10)) {
        moe_tile_starts(F);
        pg8::Gemm g{(const char*)(F.ws + WS_HID), (const char*)(F.ws + WS_W2T), EH * 2, EH * 2, EH};
        pg8::MoeOrder S{(const volatile LAS int*)(LC + LC_TST), (int)LC[LC_TST + 32] * 4, F.G, F.vcu, 256u * g.lda, 256u * g.ldb, 1024u * g.ldb};
        pg8::EpiBf16 E{(bf16_t*)(F.ws + WS_XS), D_};
        pg8::gemm_phase<pg8::EpiBf16, pg8::MoeOrder, true>(F.lds, g, S, E);
    } SEAM(10);
#if MK_REP == 11
    if (PH_ON(11) && IN(11)) { p11_final(F); }
#endif
    if (PH_ON(11) && IN(11)) { p11_final(F); }
#undef IN
#undef SEAM
}
}
#define MK_LAUNCH_PROGRAM mk_launch(a, 0, 12, stream);
static int g_grid = 0;
static void mk_launch(const Args& a0, int lo, int hi, hipStream_t st, int li = 0) {
    Args a = a0; a.ph_lo = lo; a.ph_hi = hi; a.li = li; a.pad = 0;
    hipLaunchKernelGGL(mk::fwd, dim3(g_grid), dim3(mk::NTHR), mk::LDS_BYTES, st, a);
}
extern "C" void kernel_launch(void* const* d_in, const int* in_sizes, int n_in, void* d_out, int out_size, void* d_ws, size_t ws_size, hipStream_t stream) {
    if (n_in != N_INPUTS || out_size != T_ * D_ || ws_size < WS_END) { fprintf(stderr, "kernel_launch: unexpected shapes n_in %d out %d ws %zu\n", n_in, out_size, ws_size); return; }
    if (g_grid == 0) {
        int dev = 0, cus = 0, per_cu = 0;
        if (hipGetDevice(&dev) != hipSuccess || hipDeviceGetAttribute(&cus, hipDeviceAttributeMultiprocessorCount, dev) != hipSuccess) { g_grid = -1; return; }
        if (hipFuncSetAttribute((const void*)mk::fwd, hipFuncAttributeMaxDynamicSharedMemorySize, mk::LDS_BYTES) != hipSuccess) { fprintf(stderr, "hipFuncSetAttribute failed\n"); g_grid = -1; return; }
        if (hipOccupancyMaxActiveBlocksPerMultiprocessor(&per_cu, (const void*)mk::fwd, mk::NTHR, mk::LDS_BYTES) != hipSuccess || per_cu < 1) { fprintf(stderr, "occupancy query: %d\n", per_cu); }
        (void)hipGetLastError();
        g_grid = cus;
    }
    if (g_grid < 0) return;
    (void)hipMemsetAsync((char*)d_ws + WS_CTL, 0, CTL_BYTES, stream);
    Args a{};
    for (int i = 0; i < N_INPUTS; ++i) a.in[i] = (const float*)d_in[i];
    a.out = (float*)d_out; a.ws = (unsigned char*)d_ws;
    MK_LAUNCH_PROGRAM
}
```
